# Optimizing an MI355X kernel written in HIP

```python
import math
import jax
import jax.numpy as jnp
from jax import lax
import numpy as np

D_MODEL = 1024
BATCH = 2
SEQ = 16384
DEPTH = 4

HEAD_DIM = 64
GROUP_WIDTH = D_MODEL // 4
A_HEADS = GROUP_WIDTH // HEAD_DIM
A_KV_HEADS = A_HEADS // 2
A_HALF_WINDOW = 128
A_BLOCK = 128
S5_GROUP = 16
S5_GROUPS = GROUP_WIDTH // S5_GROUP
S5_STATE = 64
S5_DT_MIN = 1e-3
S5_DT_MAX = 1e-1
C_HEADS = GROUP_WIDTH // HEAD_DIM
DILATED_CONFIGS = ((128, 1), (512, 4), (2048, 16))
C_BLOCK = 64
D_HEADS = GROUP_WIDTH // HEAD_DIM
GRID_W = 64
NA_ROWS = 8
NA_COLS = 16
NA_COL_BLOCK = 16
ALIBI_HEADS = A_HEADS + C_HEADS
D_FF = 2816
RMS_EPS = 1e-6
NEG_INF = -1e30
PROJ_SIZES = (A_HEADS * HEAD_DIM, A_KV_HEADS * HEAD_DIM, A_KV_HEADS * HEAD_DIM, GROUP_WIDTH,
              C_HEADS * HEAD_DIM, C_HEADS * HEAD_DIM, C_HEADS * HEAD_DIM,
              D_HEADS * HEAD_DIM, D_HEADS * HEAD_DIM, D_HEADS * HEAD_DIM)
D_IN_PROJ = sum(PROJ_SIZES)

kernel_name = 'hybrid_parallel_heads_encoder'


def rms_norm(x, gain):
    xf = x.astype(jnp.float32)
    y = xf * lax.rsqrt(jnp.mean(xf * xf, axis=-1, keepdims=True) + RMS_EPS)
    return (y * gain.astype(jnp.float32)).astype(x.dtype)


def swiglu(x, w_in, w_out):
    gate, up = jnp.split(x @ w_in, 2, axis=-1)
    return (jax.nn.silu(gate) * up) @ w_out


def alibi_slopes(n):
    return jnp.exp2(-8.0 * jnp.arange(1, n + 1, dtype=jnp.float32) / n)


def banded_attention(q, k, v, half_window, block, slopes, pos_scale):
    n, length, h, hd = q.shape
    hk = k.shape[2]
    rep = h // hk
    nb = -(-length // block)
    lp = nb * block
    pad = lp - length
    qb = jnp.pad(q, ((0, 0), (0, pad), (0, 0), (0, 0))).reshape(n, nb, block, hk, rep, hd)
    kvpad = ((0, 0), (block, pad + block), (0, 0), (0, 0))
    kb = jnp.pad(k, kvpad).reshape(n, nb + 2, block, hk, hd)
    vb = jnp.pad(v, kvpad).reshape(n, nb + 2, block, hk, hd)
    kwin = jnp.concatenate([kb[:, :-2], kb[:, 1:-1], kb[:, 2:]], axis=2)
    vwin = jnp.concatenate([vb[:, :-2], vb[:, 1:-1], vb[:, 2:]], axis=2)
    scores = jnp.einsum('nbqgrd,nbkgd->nbgrqk', qb, kwin, preferred_element_type=jnp.float32) * (hd ** -0.5)
    rel = np.arange(3 * block)[None, :] - block - np.arange(block)[:, None]
    key_pos = (np.arange(nb)[:, None] - 1) * block + np.arange(3 * block)[None, :]
    valid = (np.abs(rel) <= half_window)[None] & ((key_pos >= 0) & (key_pos < length))[:, None, :]
    dist = np.abs(rel).astype(np.float32)
    alibi = (-(slopes.astype(jnp.float32) * pos_scale)[:, None, None] * dist).reshape(hk, rep, block, 3 * block)
    scores = jnp.where(valid[None, :, None, None], scores + alibi[None, None], NEG_INF)
    m = jnp.max(scores, axis=-1, keepdims=True)
    p = jnp.exp(scores - m)
    l = jnp.sum(p, axis=-1, keepdims=True)
    o = jnp.einsum('nbgrqk,nbkgd->nbqgrd', p / l, vwin.astype(jnp.float32))
    o = o.reshape(n, lp, h, hd)[:, :length].astype(v.dtype)
    lse = (m + jnp.log(l))[..., 0].transpose(0, 1, 4, 2, 3).reshape(n, lp, h)[:, :length]
    return o, lse


def dilated_attention(q, k, v, slopes):
    b, s, h, hd = q.shape

    def by_stride(t, dil):
        return t.reshape(b, s // dil, dil, h, hd).transpose(0, 2, 1, 3, 4).reshape(b * dil, s // dil, h, hd)

    outs, lses = [], []
    for window, dil in DILATED_CONFIGS:
        o, lse = banded_attention(by_stride(q, dil), by_stride(k, dil), by_stride(v, dil),
                                  window // (2 * dil), C_BLOCK, slopes, float(dil))
        outs.append(o.reshape(b, dil, s // dil, h, hd).transpose(0, 2, 1, 3, 4).reshape(b, s, h, hd))
        lses.append(lse.reshape(b, dil, s // dil, h).transpose(0, 2, 1, 3).reshape(b, s, h))
    weights = jax.nn.softmax(jnp.stack(lses), axis=0)
    o = jnp.einsum('gbsh,gbshd->bshd', weights, jnp.stack(outs).astype(jnp.float32))
    return o.astype(q.dtype)


def _complex_linear_combine(first, second):
    a1r, a1i, b1r, b1i = first
    a2r, a2i, b2r, b2i = second
    return (a2r * a1r - a2i * a1i,
            a2r * a1i + a2i * a1r,
            a2r * b1r - a2i * b1i + b2r,
            a2r * b1i + a2i * b1r + b2i)


def s5_bidirectional(u, lam_re, lam_im, log_step, b_re, b_im, c_re, c_im, d_skip):
    bsz, s, width = u.shape
    uf = u.astype(jnp.float32).reshape(bsz, s, S5_GROUPS, S5_GROUP).transpose(1, 0, 2, 3)
    y = uf * d_skip.astype(jnp.float32).reshape(S5_GROUPS, S5_GROUP)
    for direction in range(2):
        lr = lam_re[direction].astype(jnp.float32)
        li = lam_im[direction].astype(jnp.float32)
        step = jnp.exp(log_step[direction].astype(jnp.float32))[:, None]
        mag = jnp.exp(lr * step)
        ar = mag * jnp.cos(li * step)
        ai = mag * jnp.sin(li * step)
        den = lr * lr + li * li
        xr = ar - 1.0
        coef_r = (xr * lr + ai * li) / den
        coef_i = (ai * lr - xr * li) / den
        br = b_re[direction].astype(jnp.float32)
        bi = b_im[direction].astype(jnp.float32)
        bbar_r = coef_r[..., None] * br - coef_i[..., None] * bi
        bbar_i = coef_r[..., None] * bi + coef_i[..., None] * br
        bu_r = jnp.einsum('sbgc,gpc->sbgp', uf, bbar_r)
        bu_i = jnp.einsum('sbgc,gpc->sbgp', uf, bbar_i)
        a_shape = (s, 1, S5_GROUPS, S5_STATE)
        _, _, xs_r, xs_i = lax.associative_scan(
            _complex_linear_combine,
            (jnp.broadcast_to(ar[None, None], a_shape), jnp.broadcast_to(ai[None, None], a_shape), bu_r, bu_i),
            reverse=bool(direction), axis=0)
        y = y + jnp.einsum('sbgp,gcp->sbgc', xs_r, c_re[direction].astype(jnp.float32)) \
              - jnp.einsum('sbgp,gcp->sbgc', xs_i, c_im[direction].astype(jnp.float32))
    return y.transpose(1, 0, 2, 3).reshape(bsz, s, width)


def _na_axis(n, k, qblk):
    nblk = n // qblk
    width = min(qblk + k, n)
    q_idx = np.arange(n).reshape(nblk, qblk)
    win_start = np.clip(q_idx - k // 2, 0, n - k)
    slab_start = np.clip(np.arange(nblk) * qblk - k // 2, 0, n - width)
    key_idx = slab_start[:, None] + np.arange(width)[None, :]
    keys = key_idx[:, None, :]
    valid = (keys >= win_start[..., None]) & (keys < win_start[..., None] + k)
    offset = keys - q_idx[..., None]
    return key_idx, valid, offset


def neighborhood_attention(q, k, v, rel_bias):
    bsz, s, h, hd = q.shape
    rows = s // GRID_W
    kr = min(NA_ROWS, rows)
    qr = math.gcd(rows, NA_ROWS)
    row_keys, row_valid, row_off = _na_axis(rows, kr, qr)
    col_keys, col_valid, col_off = _na_axis(GRID_W, NA_COLS, NA_COL_BLOCK)
    nrb, ncb = rows // qr, GRID_W // NA_COL_BLOCK
    ri = np.clip(row_off + NA_ROWS - 1, 0, 2 * NA_ROWS - 2)
    ci = np.clip(col_off + NA_COLS - 1, 0, 2 * NA_COLS - 2)
    bias = rel_bias.astype(jnp.float32)[:, ri[:, None, :, None, :, None], ci[None, :, None, :, None, :]]
    mask = row_valid[:, None, :, None, :, None] & col_valid[None, :, None, :, None, :]
    bias = jnp.where(mask[None], bias, NEG_INF).transpose(1, 2, 0, 3, 4, 5, 6)
    qg = q.reshape(bsz, nrb, qr, ncb, NA_COL_BLOCK, h, hd)
    idx_r = row_keys[:, None, :, None]
    idx_c = col_keys[None, :, None, :]
    kg = k.reshape(bsz, rows, GRID_W, h, hd)[:, idx_r, idx_c]
    vg = v.reshape(bsz, rows, GRID_W, h, hd)[:, idx_r, idx_c]
    scores = jnp.einsum('birjchd,bijuvhd->bijhrcuv', qg, kg, preferred_element_type=jnp.float32) * (hd ** -0.5) + bias[None]
    p = jax.nn.softmax(scores, axis=(-2, -1))
    o = jnp.einsum('bijhrcuv,bijuvhd->birjchd', p, vg.astype(jnp.float32))
    return o.reshape(bsz, s, h, hd).astype(v.dtype)


def hybrid_mixer(h, w_in, qk_gain, a_sink, lam_re, lam_im, log_step, b_re, b_im, c_re, c_im, d_skip,
                 w_glu, rel_bias, w_out, slopes):
    bsz, s, _ = h.shape
    splits = np.cumsum(PROJ_SIZES)[:-1].tolist()
    aq, ak, av, bu, cq, ck, cv, dq, dk, dv = jnp.split(h @ w_in, splits, axis=-1)

    def heads(t):
        return t.reshape(bsz, s, -1, HEAD_DIM)

    o_a, lse_a = banded_attention(rms_norm(heads(aq), qk_gain[0]), rms_norm(heads(ak), qk_gain[1]), heads(av),
                                  A_HALF_WINDOW, A_BLOCK, slopes[:A_HEADS], 1.0)
    o_a = o_a.astype(jnp.float32) * jax.nn.sigmoid(lse_a - a_sink.astype(jnp.float32))[..., None]
    y_b = s5_bidirectional(bu, lam_re, lam_im, log_step, b_re, b_im, c_re, c_im, d_skip)
    g = jax.nn.gelu(y_b)
    y_b = g * jax.nn.sigmoid(g @ w_glu.astype(jnp.float32))
    o_c = dilated_attention(rms_norm(heads(cq), qk_gain[2]), rms_norm(heads(ck), qk_gain[3]), heads(cv),
                            slopes[A_HEADS:])
    o_d = neighborhood_attention(rms_norm(heads(dq), qk_gain[4]), rms_norm(heads(dk), qk_gain[5]), heads(dv), rel_bias)
    mixed = jnp.concatenate([o_a.reshape(bsz, s, -1).astype(h.dtype), y_b.astype(h.dtype),
                             o_c.reshape(bsz, s, -1).astype(h.dtype), o_d.reshape(bsz, s, -1).astype(h.dtype)], axis=-1)
    return mixed @ w_out


def setup_inputs(seed: int = 0) -> dict:
    key = jax.random.key(seed)
    ks = jax.random.split(key, 24)
    f32 = jnp.float32

    def normal(k, shape, scale):
        return scale * jax.random.normal(k, shape, f32)

    def gain(k, shape):
        return 1.0 + normal(k, shape, 0.02)

    x = normal(ks[0], (BATCH, SEQ, D_MODEL), 1.0)
    ffn1_norm = gain(ks[1], (DEPTH, D_MODEL))
    ffn1_w_in = normal(ks[2], (DEPTH, D_MODEL, 2 * D_FF), D_MODEL ** -0.5)
    ffn1_w_out = normal(ks[3], (DEPTH, D_FF, D_MODEL), D_FF ** -0.5)
    mix_norm = gain(ks[4], (DEPTH, D_MODEL))
    w_in = normal(ks[5], (DEPTH, D_MODEL, D_IN_PROJ), D_MODEL ** -0.5)
    qk_gain = gain(ks[6], (DEPTH, 6, HEAD_DIM))
    a_sink = normal(ks[7], (DEPTH, A_HEADS), 1.0)
    s5_lam_re = -0.5 + normal(ks[8], (DEPTH, 2, S5_GROUPS, S5_STATE), 0.01)
    s5_lam_im = jnp.broadcast_to(math.pi * jnp.arange(S5_STATE, dtype=f32), (DEPTH, 2, S5_GROUPS, S5_STATE))
    s5_log_step = jax.random.uniform(ks[9], (DEPTH, 2, S5_GROUPS), f32, math.log(S5_DT_MIN), math.log(S5_DT_MAX))
    s5_b_re = normal(ks[10], (DEPTH, 2, S5_GROUPS, S5_STATE, S5_GROUP), (2 * S5_GROUP) ** -0.5)
    s5_b_im = normal(ks[11], (DEPTH, 2, S5_GROUPS, S5_STATE, S5_GROUP), (2 * S5_GROUP) ** -0.5)
    s5_c_re = normal(ks[12], (DEPTH, 2, S5_GROUPS, S5_GROUP, S5_STATE), S5_STATE ** -0.5)
    s5_c_im = normal(ks[13], (DEPTH, 2, S5_GROUPS, S5_GROUP, S5_STATE), S5_STATE ** -0.5)
    s5_d = normal(ks[14], (DEPTH, GROUP_WIDTH), 1.0)
    s5_w_glu = normal(ks[15], (DEPTH, GROUP_WIDTH, GROUP_WIDTH), GROUP_WIDTH ** -0.5)
    na_rel_bias = normal(ks[16], (DEPTH, D_HEADS, 2 * NA_ROWS - 1, 2 * NA_COLS - 1), 0.5)
    w_out = normal(ks[17], (DEPTH, D_MODEL, D_MODEL), D_MODEL ** -0.5)
    ffn2_norm = gain(ks[18], (DEPTH, D_MODEL))
    ffn2_w_in = normal(ks[19], (DEPTH, D_MODEL, 2 * D_FF), D_MODEL ** -0.5)
    ffn2_w_out = normal(ks[20], (DEPTH, D_FF, D_MODEL), D_FF ** -0.5)
    return {'x': x, 'ffn1_norm': ffn1_norm, 'ffn1_w_in': ffn1_w_in, 'ffn1_w_out': ffn1_w_out,
            'mix_norm': mix_norm, 'w_in': w_in, 'qk_gain': qk_gain, 'a_sink': a_sink,
            's5_lam_re': s5_lam_re, 's5_lam_im': s5_lam_im, 's5_log_step': s5_log_step,
            's5_b_re': s5_b_re, 's5_b_im': s5_b_im, 's5_c_re': s5_c_re, 's5_c_im': s5_c_im,
            's5_d': s5_d, 's5_w_glu': s5_w_glu, 'na_rel_bias': na_rel_bias, 'w_out': w_out,
            'ffn2_norm': ffn2_norm, 'ffn2_w_in': ffn2_w_in, 'ffn2_w_out': ffn2_w_out}


def reference(x, ffn1_norm, ffn1_w_in, ffn1_w_out, mix_norm, w_in, qk_gain, a_sink,
              s5_lam_re, s5_lam_im, s5_log_step, s5_b_re, s5_b_im, s5_c_re, s5_c_im,
              s5_d, s5_w_glu, na_rel_bias, w_out, ffn2_norm, ffn2_w_in, ffn2_w_out):
    slopes = alibi_slopes(ALIBI_HEADS)
    for layer in range(DEPTH):
        x = x + 0.5 * swiglu(rms_norm(x, ffn1_norm[layer]), ffn1_w_in[layer], ffn1_w_out[layer])
        x = x + hybrid_mixer(rms_norm(x, mix_norm[layer]), w_in[layer], qk_gain[layer], a_sink[layer],
                             s5_lam_re[layer], s5_lam_im[layer], s5_log_step[layer], s5_b_re[layer], s5_b_im[layer],
                             s5_c_re[layer], s5_c_im[layer], s5_d[layer], s5_w_glu[layer], na_rel_bias[layer],
                             w_out[layer], slopes)
        x = x + 0.5 * swiglu(rms_norm(x, ffn2_norm[layer]), ffn2_w_in[layer], ffn2_w_out[layer])
    return x
```

```cpp
#include <hip/hip_runtime.h>
#include <hip/hip_cooperative_groups.h>
#include <cstdio>
#include <cstdint>
namespace cg = cooperative_groups;
__device__ __forceinline__ int fresh_lane_id() { unsigned z = 0u; asm volatile("" : "+v"(z)); return (int)__builtin_amdgcn_mbcnt_hi(~0u, __builtin_amdgcn_mbcnt_lo(~0u, z)); }
namespace pg8 {
#define PG8_LAS __attribute__((address_space(3)))
typedef unsigned short bf16_t;
typedef short bf16x8 __attribute__((ext_vector_type(8)));
typedef float f32x4 __attribute__((ext_vector_type(4)));
typedef unsigned u32x4 __attribute__((ext_vector_type(4)));
constexpr int BM = 256, BK = 64, HALF = 128, HTB = HALF * BK * 2  , STAGE_BYTES = 8 * HTB, NXCD = 8, WGM = 8;

__host__ __device__ __forceinline__ int lds_byte(int r, int c) { const int st = (r >> 4) * 2 + (c >> 5), rr = r & 15, cc = c & 31, ob = rr * 64 + cc * 2; return st * 1024 + (ob ^ (((ob >> 9) & 1) << 5)); }
__host__ __device__ __forceinline__ void stage_rc(int b, int& R, int& C) { const int st = b / 1024, sb = b % 1024, swz = sb ^ (((sb >> 9) & 1) << 5); R = (st >> 1) * 16 + swz / 64; C = (st & 1) * 32 + (swz % 64) / 2; }
__host__ __device__ __forceinline__ int perm32(int rho) { const int n = rho >> 4, i = rho & 15; return 8 * (i >> 2) + 4 * n + (i & 3); }

struct Unit { int pm, pn; };
struct Gemm { const bf16_t* A; const bf16_t* Bt; int M, N, K; };

struct StaticOrder {
    int nM, nN, nwg, G, c;
    __host__ __device__ void init(int M, int N, int G_, int c_) { nM = M / BM; nN = N / BM; nwg = nM * nN; G = G_; c = c_; }
    __host__ __device__ bool next(int i, Unit& u) const {
        const long L = (long)i * G + c; if (L >= nwg) return false;
        int wgid = (int)L; { const int q = nwg / NXCD, r = nwg % NXCD, xcd = wgid % NXCD, off = wgid / NXCD; wgid = (xcd < r ? xcd * (q + 1) : r * (q + 1) + (xcd - r) * q) + off; }
        const int nig = WGM * nN, gid = wgid / nig, fm = gid * WGM, gsz = (nM - fm) < WGM ? (nM - fm) : WGM;
        u.pm = fm + ((wgid % nig) % gsz); u.pn = (wgid % nig) / gsz; return true;
    }
    __device__ __forceinline__ void a_ready(const Unit&) const {}
    __device__ __forceinline__ void done(const Unit&) const {}
};

__device__ __forceinline__ unsigned cvt_pk_bf16(float lo, float hi) { unsigned r; asm volatile("v_cvt_pk_bf16_f32 %0, %1, %2" : "=v"(r) : "v"(lo), "v"(hi)); return r; }
#ifndef RESID_F16
#define RESID_F16 1
#endif
__device__ __forceinline__ float bf_lo(unsigned w) { return __builtin_bit_cast(float, w << 16); }
__device__ __forceinline__ float bf_hi(unsigned w) { return __builtin_bit_cast(float, w & 0xffff0000u); }
typedef _Float16 f16x8 __attribute__((ext_vector_type(8)));
typedef _Float16 f16x2 __attribute__((ext_vector_type(2)));
typedef float f32x2e __attribute__((ext_vector_type(2)));
template <bool F16> __device__ __forceinline__ f32x4 mma16(bf16x8 a, bf16x8 b, f32x4 c) {
    if constexpr (F16) return __builtin_amdgcn_mfma_f32_16x16x32_f16(__builtin_bit_cast(f16x8, a), __builtin_bit_cast(f16x8, b), c, 0, 0, 0);
    else return __builtin_amdgcn_mfma_f32_16x16x32_bf16(a, b, c, 0, 0, 0);
}
__device__ __forceinline__ unsigned pk_f16(float lo, float hi) { f32x2e v = {lo, hi}; return __builtin_bit_cast(unsigned, __builtin_convertvector(v, f16x2)); }
#ifndef XB_BITS
#define XB_BITS 8
#endif
__device__ __forceinline__ float rnd_sig(float v) { unsigned u = __builtin_bit_cast(unsigned, v); constexpr unsigned D = 23 - XB_BITS; u = (u + ((1u << (D - 1)) - 1u) + ((u >> D) & 1u)) & ~((1u << D) - 1u); return __builtin_bit_cast(float, u); }
__device__ __forceinline__ unsigned pk_f16r(float lo, float hi) { f32x2e v = {rnd_sig(lo), rnd_sig(hi)}; return __builtin_bit_cast(unsigned, __builtin_convertvector(v, f16x2)); }
__device__ __forceinline__ float h_lo(unsigned w) { return (float)__builtin_bit_cast(f16x2, w)[0]; }
__device__ __forceinline__ float h_hi(unsigned w) { return (float)__builtin_bit_cast(f16x2, w)[1]; }
__device__ __forceinline__ float sigmoid_f(float v) { return __builtin_amdgcn_rcpf(1.0f + __expf(-v)); }
__device__ __forceinline__ float row_rstd(const float* ssq, int row) {
    const f32x4* p = (const f32x4*)(ssq + (size_t)row * 16); const f32x4 a = p[0], b = p[1], c = p[2], d = p[3];
    const float s = ((a[0] + a[1]) + (a[2] + a[3])) + ((b[0] + b[1]) + (b[2] + b[3])) + (((c[0] + c[1]) + (c[2] + c[3])) + ((d[0] + d[1]) + (d[2] + d[3])));
    return __builtin_amdgcn_rsqf(s * (1.0f / 1024.0f) + 1e-6f);
}

constexpr int RS_LDS_OFF = 131072 + 2048;
__device__ __forceinline__ void rows_rstd_pre(const float* ssq, const Unit& u, int tid, f32x4 (&pre)[2]) {
    const f32x4* p = (const f32x4*)(ssq + (size_t)(u.pm * BM + (tid >> 1)) * 16 + 8 * (tid & 1));
    pre[0] = p[0]; pre[1] = p[1];
}
__device__ __forceinline__ void rows_rstd_lds(const f32x4 (&pre)[2], int wr, int wc, int fr, int fq, float (&rs)[2][4]) {
    PG8_LAS float* rl = (PG8_LAS float*)((PG8_LAS unsigned char*)0 + RS_LDS_OFF);
    const int t = (wr * 4 + wc) * 64 + fq * 16 + fr, rowl = t >> 1, hf = t & 1;
    const f32x4 a = pre[0], b = pre[1];
    float sm = ((a[0] + a[1]) + (a[2] + a[3])) + ((b[0] + b[1]) + (b[2] + b[3]));
    sm += __shfl_xor(sm, 1);
    if (hf == 0) rl[rowl] = __builtin_amdgcn_rsqf(sm * (1.0f / 1024.0f) + 1e-6f);
    asm volatile("s_waitcnt lgkmcnt(0)" ::: "memory");
    __builtin_amdgcn_s_barrier();
#pragma unroll
    for (int ai = 0; ai < 2; ++ai)
#pragma unroll
        for (int m = 0; m < 4; ++m) rs[ai][m] = rl[ai * HALF + wr * 64 + m * 16 + fr];
}

struct EpiSwiGLU {
    static constexpr bool PERM = true, AFTER_DRAIN = false, HAS_PRE = true;
    bf16_t* H; const float* ssq;
    __device__ __forceinline__ void prefetch(const Unit& u, int tid, f32x4 (&pre)[2]) const { rows_rstd_pre(ssq, u, tid, pre); }
    __device__ __forceinline__ void operator()(const f32x4 (&acc)[2][2][4][2], const Unit& u, int wr, int wc, int fr, int fq, const f32x4 (&pre)[2]) const {
        const int row0 = u.pm * BM + wr * 64 + fr; const int hc = u.pn * 128 + wc * 32 + 8 * fq;
        float rsv[2][4]; rows_rstd_lds(pre, wr, wc, fr, fq, rsv);
#pragma unroll
        for (int ai = 0; ai < 2; ++ai)
#pragma unroll
            for (int m = 0; m < 4; ++m) {
                const int row = row0 + ai * HALF + m * 16;
                const float rs = rsv[ai][m];
                float h[8];
#pragma unroll
                for (int n = 0; n < 2; ++n)
#pragma unroll
                    for (int j = 0; j < 4; ++j) { const float g = acc[ai][0][m][n][j] * rs, up = acc[ai][1][m][n][j] * rs; h[4 * n + j] = g * sigmoid_f(g) * up; }
                u32x4 w; w.x = cvt_pk_bf16(h[0], h[1]); w.y = cvt_pk_bf16(h[2], h[3]); w.z = cvt_pk_bf16(h[4], h[5]); w.w = cvt_pk_bf16(h[6], h[7]);
                *(u32x4*)(H + (size_t)row * 2816 + hc) = w;
            }
    }
};

struct EpiRes {
    static constexpr bool PERM = true, AFTER_DRAIN = false, HAS_PRE = false;
    float* xout32; bf16_t* XB; float* ssq_next; float sc;
    __device__ __forceinline__ void operator()(const f32x4 (&acc)[2][2][4][2], const Unit& u, int wr, int wc, int fr, int fq) const {
        const int row0 = u.pm * BM + wr * 64 + fr; const int c0 = u.pn * BM + wc * 32 + 8 * fq;
#pragma unroll
        for (int ai = 0; ai < 2; ++ai) {
            u32x4 xa[4][2];
#pragma unroll
            for (int m = 0; m < 4; ++m)
#pragma unroll
                for (int bj = 0; bj < 2; ++bj) xa[m][bj] = *(const u32x4*)(XB + (size_t)(row0 + ai * HALF + m * 16) * 1024 + c0 + bj * HALF);
#pragma unroll
            for (int m = 0; m < 4; ++m) {
                const int row = row0 + ai * HALF + m * 16; float ss = 0.f;
#pragma unroll
                for (int bj = 0; bj < 2; ++bj) {
                    const size_t o = (size_t)row * 1024 + c0 + bj * HALF;
                    const u32x4 xw = xa[m][bj];
#if RESID_F16
                    f32x4 a = {h_lo(xw.x), h_hi(xw.x), h_lo(xw.y), h_hi(xw.y)}, b = {h_lo(xw.z), h_hi(xw.z), h_lo(xw.w), h_hi(xw.w)};
#else
                    f32x4 a = {bf_lo(xw.x), bf_hi(xw.x), bf_lo(xw.y), bf_hi(xw.y)}, b = {bf_lo(xw.z), bf_hi(xw.z), bf_lo(xw.w), bf_hi(xw.w)};
#endif
                    a = a + acc[ai][bj][m][0] * sc; b = b + acc[ai][bj][m][1] * sc;
                    if (xout32) { *(f32x4*)(xout32 + o) = a; *(f32x4*)(xout32 + o + 4) = b; }
#if RESID_F16
                    u32x4 w; w.x = pk_f16r(a[0], a[1]); w.y = pk_f16r(a[2], a[3]); w.z = pk_f16r(b[0], b[1]); w.w = pk_f16r(b[2], b[3]);
#else
                    u32x4 w; w.x = cvt_pk_bf16(a[0], a[1]); w.y = cvt_pk_bf16(a[2], a[3]); w.z = cvt_pk_bf16(b[0], b[1]); w.w = cvt_pk_bf16(b[2], b[3]);
#endif
                    if (!xout32) *(u32x4*)(XB + o) = w;
                    ss += (a[0] * a[0] + a[1] * a[1]) + (a[2] * a[2] + a[3] * a[3]) + (b[0] * b[0] + b[1] * b[1]) + (b[2] * b[2] + b[3] * b[3]);
                }
                ss += __shfl_xor(ss, 16); ss += __shfl_xor(ss, 32);
                if (fq == 0 && !xout32) ssq_next[(size_t)row * 16 + u.pn * 4 + wc] = ss;
            }
            asm volatile("" ::: "memory");
        }
    }
};

struct EpiInProj {
    static constexpr bool PERM = true, AFTER_DRAIN = false, HAS_PRE = true;
    bf16_t* P; const float* ssq; const float* qkg;
    __device__ __forceinline__ void prefetch(const Unit& u, int tid, f32x4 (&pre)[2]) const { rows_rstd_pre(ssq, u, tid, pre); }
    __device__ __forceinline__ void operator()(const f32x4 (&acc)[2][2][4][2], const Unit& u, int wr, int wc, int fr, int fq, const f32x4 (&pre)[2]) const {
        const int row0 = u.pm * BM + wr * 64 + fr; const int hh = 4 * u.pn + wc;
        int gidx = -1;
        if (hh < 4) gidx = 0; else if (hh < 6) gidx = 1; else if (hh < 12) gidx = -1; else if (hh < 16) gidx = 2; else if (hh < 20) gidx = 3; else if (hh < 24) gidx = -1; else if (hh < 28) gidx = 4; else if (hh < 32) gidx = 5;
        const int cb = u.pn * BM + wc * 64 + 8 * fq;
        float rsv[2][4]; rows_rstd_lds(pre, wr, wc, fr, fq, rsv);
        f32x4 gv[2][2];
#pragma unroll
        for (int bj = 0; bj < 2; ++bj)
#pragma unroll
            for (int n = 0; n < 2; ++n) gv[bj][n] = (gidx >= 0) ? *(const f32x4*)(qkg + gidx * 64 + 32 * bj + 8 * fq + 4 * n) : (f32x4){1.f, 1.f, 1.f, 1.f};
#pragma unroll
        for (int ai = 0; ai < 2; ++ai)
#pragma unroll
            for (int m = 0; m < 4; ++m) {
                const int row = row0 + ai * HALF + m * 16;
                const float rs = rsv[ai][m];
                f32x4 v[2][2]; float ss = 0.f;
#pragma unroll
                for (int bj = 0; bj < 2; ++bj)
#pragma unroll
                    for (int n = 0; n < 2; ++n) { v[bj][n] = acc[ai][bj][m][n] * rs; const f32x4 t = v[bj][n]; ss += (t[0] * t[0] + t[1] * t[1]) + (t[2] * t[2] + t[3] * t[3]); }
                if (gidx >= 0) {
                    ss += __shfl_xor(ss, 16); ss += __shfl_xor(ss, 32);
                    const float r2 = __builtin_amdgcn_rsqf(ss * (1.0f / 64.0f) + 1e-6f);
#pragma unroll
                    for (int bj = 0; bj < 2; ++bj)
#pragma unroll
                        for (int n = 0; n < 2; ++n) v[bj][n] = v[bj][n] * r2 * gv[bj][n];
                }
#pragma unroll
                for (int bj = 0; bj < 2; ++bj) {
                    u32x4 w; w.x = cvt_pk_bf16(v[bj][0][0], v[bj][0][1]); w.y = cvt_pk_bf16(v[bj][0][2], v[bj][0][3]); w.z = cvt_pk_bf16(v[bj][1][0], v[bj][1][1]); w.w = cvt_pk_bf16(v[bj][1][2], v[bj][1][3]);
                    *(u32x4*)(P + (size_t)row * 2304 + cb + 32 * bj) = w;
                }
            }
    }
};

struct EpiGLU {
    static constexpr bool PERM = true, AFTER_DRAIN = false, HAS_PRE = false;
    const bf16_t* G; bf16_t* MIX;
    __device__ __forceinline__ void operator()(const f32x4 (&acc)[2][2][4][2], const Unit& u, int wr, int wc, int fr, int fq) const {
        const int row0 = u.pm * BM + wr * 64 + fr; const int c0 = wc * 32 + 8 * fq;
#pragma unroll
        for (int ai = 0; ai < 2; ++ai) {
            u32x4 gq[4][2];
#pragma unroll
            for (int m = 0; m < 4; ++m)
#pragma unroll
                for (int bj = 0; bj < 2; ++bj) gq[m][bj] = *(const u32x4*)(G + (size_t)(row0 + ai * HALF + m * 16) * 256 + c0 + bj * HALF);
#pragma unroll
            for (int m = 0; m < 4; ++m) {
                const int row = row0 + ai * HALF + m * 16;
#pragma unroll
                for (int bj = 0; bj < 2; ++bj) {
                    const int c = c0 + bj * HALF;
                    const u32x4 gw = gq[m][bj];
                    const f32x4 a0 = acc[ai][bj][m][0], a1 = acc[ai][bj][m][1];
                    u32x4 w;
                    w.x = cvt_pk_bf16(bf_lo(gw.x) * sigmoid_f(a0[0]), bf_hi(gw.x) * sigmoid_f(a0[1]));
                    w.y = cvt_pk_bf16(bf_lo(gw.y) * sigmoid_f(a0[2]), bf_hi(gw.y) * sigmoid_f(a0[3]));
                    w.z = cvt_pk_bf16(bf_lo(gw.z) * sigmoid_f(a1[0]), bf_hi(gw.z) * sigmoid_f(a1[1]));
                    w.w = cvt_pk_bf16(bf_lo(gw.w) * sigmoid_f(a1[2]), bf_hi(gw.w) * sigmoid_f(a1[3]));
                    *(u32x4*)(MIX + (size_t)row * 1024 + 256 + c) = w;
                }
            }
            asm volatile("" ::: "memory");
        }
    }
};

template <class Epi, class Sched, bool ALIGN_EPI = false, bool SP2 = false, bool F16 = false>
__device__ __forceinline__ void gemm_phase(PG8_LAS unsigned char* lds, const Gemm g, const Sched& S, const Epi& E, const int wave_id) {
    int tid_ = wave_id * 64 + fresh_lane_id(); asm volatile("" : "+v"(tid_));
    const int tid = tid_, wid = __builtin_amdgcn_readfirstlane(tid >> 6), lane = tid & 63, wr = wid >> 2, wc = wid & 3, fr = lane & 15, fq = lane >> 4;
    const int K = g.K, nt = K / BK;
    unsigned voffA[2], voffB[2];
#pragma unroll
    for (int i = 0; i < 2; ++i) { int R, C; stage_rc(tid * 16 + i * 8192, R, C); const int Rb = Epi::PERM ? ((R & ~31) + perm32(R & 31)) : R;
        voffA[i] = (unsigned)(R * K + C) * 2u; voffB[i] = (unsigned)(Rb * K + C) * 2u; }
    const size_t kstep = (size_t)(BK * 2);
    const size_t hstep = (size_t)HALF * K * 2;
    const size_t tstep = 2 * hstep;
    const unsigned ldsw = (unsigned)wid * 1024u;
    const int aoff = lds_byte(wr * 64 + fr, fq * 8), boff = lds_byte(wc * 32 + fr, fq * 8);
#define PG8_SA(b, h) (((b) * 2 + (h)) * HTB)
#define PG8_SB(b, h) ((4 + (b) * 2 + (h)) * HTB)
#define PG8_STAGE(bufoff, gbase, voff) do { _Pragma("unroll") for (int _i = 0; _i < 2; ++_i) \
        __builtin_amdgcn_global_load_lds((const unsigned*)((const char*)(gbase) + (voff)[_i]), (PG8_LAS unsigned*)(lds + (bufoff) + ldsw + _i * 8192), 16, 0, 0); } while (0)
#define PG8_LDA(dst, b, h) do { _Pragma("unroll") for (int m = 0; m < 4; ++m) _Pragma("unroll") for (int k = 0; k < 2; ++k) dst[m][k] = *(const PG8_LAS bf16x8*)(lds + PG8_SA(b, h) + aoff + m * 2048 + k * 1024); } while (0)
#define PG8_LDB(dst, b, h) do { _Pragma("unroll") for (int n = 0; n < 2; ++n) _Pragma("unroll") for (int k = 0; k < 2; ++k) dst[n][k] = *(const PG8_LAS bf16x8*)(lds + PG8_SB(b, h) + boff + n * 2048 + k * 1024); } while (0)
#define PG8_MMA(ai, bj, At, Bt) do { __builtin_amdgcn_s_setprio(1); _Pragma("unroll") for (int m = 0; m < 4; ++m) _Pragma("unroll") for (int n = 0; n < 2; ++n) _Pragma("unroll") for (int k = 0; k < 2; ++k) \
        acc[ai][bj][m][n] = mma16<F16>(Bt[n][k], At[m][k], acc[ai][bj][m][n]); __builtin_amdgcn_s_setprio(0); } while (0)
#define PG8_WAIT_V(n) asm volatile("s_waitcnt vmcnt(" #n ")" ::: "memory")
#define PG8_WAIT_L(n) asm volatile("s_waitcnt lgkmcnt(" #n ")" ::: "memory")
#define PG8_BAR __builtin_amdgcn_s_barrier()
#define PG8_SCHED __builtin_amdgcn_sched_barrier(0)
    Unit cur, nxt; int ui = 0;
    if (!S.next(0, cur)) return;
    f32x4 acc[2][2][4][2];
#pragma unroll
    for (int a = 0; a < 2; ++a)
#pragma unroll
        for (int b = 0; b < 2; ++b)
#pragma unroll
            for (int m = 0; m < 4; ++m)
#pragma unroll
                for (int n = 0; n < 2; ++n) acc[a][b][m][n] = (f32x4){0.f, 0.f, 0.f, 0.f};
    bf16x8 At[4][2], B0[2][2], B1[2][2];
    f32x4 epre[2];
    const char* cA = (const char*)g.A + (size_t)cur.pm * tstep; const char* cB = (const char*)g.Bt + (size_t)cur.pn * tstep;
    S.a_ready(cur);
    if constexpr (SP2) {
        PG8_STAGE(PG8_SB(0, 0), cB, voffB); PG8_STAGE(PG8_SB(0, 1), cB + hstep, voffB); PG8_STAGE(PG8_SA(0, 0), cA, voffA); PG8_STAGE(PG8_SA(0, 1), cA + hstep, voffA);
        if (wr == 1) PG8_BAR;
        PG8_WAIT_V(2); PG8_BAR;
        PG8_STAGE(PG8_SB(1, 0), cB + kstep, voffB); PG8_STAGE(PG8_SA(1, 0), cA + kstep, voffA); PG8_STAGE(PG8_SB(1, 1), cB + hstep + kstep, voffB);
        PG8_WAIT_V(6); PG8_BAR;
    } else {
        PG8_STAGE(PG8_SB(0, 0), cB, voffB); PG8_STAGE(PG8_SA(0, 0), cA, voffA); PG8_STAGE(PG8_SB(0, 1), cB + hstep, voffB); PG8_STAGE(PG8_SA(0, 1), cA + hstep, voffA);
        if (wr == 1) PG8_BAR;
        PG8_WAIT_V(4); PG8_BAR;
        PG8_STAGE(PG8_SB(1, 0), cB + kstep, voffB); PG8_STAGE(PG8_SA(1, 0), cA + kstep, voffA); PG8_STAGE(PG8_SB(1, 1), cB + hstep + kstep, voffB);
        PG8_WAIT_V(6); PG8_BAR;
    }
    for (;;) {
        const bool has_next = S.next(ui + 1, nxt);
        const char* nA = has_next ? (const char*)g.A + (size_t)nxt.pm * tstep : cA; const char* nB = has_next ? (const char*)g.Bt + (size_t)nxt.pn * tstep : cB;
        for (int t = 0; t < nt; t += 2) {
            const bool last = (t == nt - 2);
            if constexpr (Epi::HAS_PRE) { if (last) E.prefetch(cur, tid, epre); }
            const char* a1 = cA + (size_t)(t + 1) * kstep;
            const char* a2 = last ? nA : cA + (size_t)(t + 2) * kstep; const char* b2 = last ? nB : cB + (size_t)(t + 2) * kstep;
            const char* a3 = a2 + kstep; const char* b3 = b2 + kstep;
            if (last && has_next) S.a_ready(nxt);
            if constexpr (SP2) {
            PG8_LDB(B0, 0, 0); PG8_LDB(B1, 0, 1); PG8_SCHED; PG8_LDA(At, 0, 0); PG8_STAGE(PG8_SA(1, 1), a1 + hstep, voffA);
            PG8_WAIT_V(8); PG8_WAIT_L(0); PG8_BAR; PG8_MMA(0, 0, At, B0); PG8_MMA(0, 1, At, B1); PG8_BAR; PG8_SCHED;
            PG8_LDA(At, 0, 1); PG8_STAGE(PG8_SB(0, 0), b2, voffB); PG8_STAGE(PG8_SB(0, 1), b2 + hstep, voffB); PG8_STAGE(PG8_SA(0, 0), a2, voffA);
            PG8_WAIT_V(8); PG8_WAIT_L(0); PG8_BAR; PG8_MMA(1, 0, At, B0); PG8_MMA(1, 1, At, B1); PG8_BAR; PG8_SCHED;
            PG8_LDB(B0, 1, 0); PG8_LDB(B1, 1, 1); PG8_SCHED; PG8_LDA(At, 1, 0); PG8_STAGE(PG8_SA(0, 1), a2 + hstep, voffA);
            PG8_WAIT_V(8); PG8_WAIT_L(0); PG8_BAR; PG8_MMA(0, 0, At, B0); PG8_MMA(0, 1, At, B1); PG8_BAR; PG8_SCHED;
            PG8_LDA(At, 1, 1); PG8_STAGE(PG8_SB(1, 0), b3, voffB); PG8_STAGE(PG8_SB(1, 1), b3 + hstep, voffB); PG8_STAGE(PG8_SA(1, 0), a3, voffA);
            PG8_WAIT_V(8); PG8_WAIT_L(0); PG8_BAR; PG8_MMA(1, 0, At, B0); PG8_MMA(1, 1, At, B1); PG8_BAR; PG8_SCHED;
            } else {
            PG8_LDB(B0, 0, 0); PG8_SCHED; PG8_LDA(At, 0, 0); PG8_STAGE(PG8_SA(1, 1), a1 + hstep, voffA);
            PG8_WAIT_L(8); PG8_BAR; PG8_WAIT_L(0); PG8_MMA(0, 0, At, B0); PG8_BAR; PG8_SCHED;
            PG8_LDB(B1, 0, 1); PG8_STAGE(PG8_SB(0, 0), b2, voffB);
            PG8_BAR; PG8_WAIT_L(0); PG8_MMA(0, 1, At, B1); PG8_BAR;
            PG8_LDA(At, 0, 1); PG8_STAGE(PG8_SA(0, 0), a2, voffA);
            PG8_BAR; PG8_WAIT_L(0); PG8_MMA(1, 0, At, B0); PG8_BAR; PG8_SCHED;
            PG8_STAGE(PG8_SB(0, 1), b2 + hstep, voffB);
            PG8_WAIT_V(6); PG8_BAR; PG8_MMA(1, 1, At, B1); PG8_BAR;
            PG8_LDB(B0, 1, 0); PG8_SCHED; PG8_LDA(At, 1, 0); PG8_STAGE(PG8_SA(0, 1), a2 + hstep, voffA);
            PG8_WAIT_L(8); PG8_BAR; PG8_WAIT_L(0); PG8_MMA(0, 0, At, B0); PG8_BAR; PG8_SCHED;
            PG8_LDB(B1, 1, 1); PG8_STAGE(PG8_SB(1, 0), b3, voffB);
            PG8_BAR; PG8_WAIT_L(0); PG8_MMA(0, 1, At, B1); PG8_BAR;
            PG8_LDA(At, 1, 1); PG8_STAGE(PG8_SA(1, 0), a3, voffA);
            PG8_BAR; PG8_WAIT_L(0); PG8_MMA(1, 0, At, B0); PG8_BAR; PG8_SCHED;
            PG8_STAGE(PG8_SB(1, 1), b3 + hstep, voffB);
            PG8_WAIT_V(6); PG8_BAR; PG8_MMA(1, 1, At, B1); PG8_BAR;
            }
        }
        if constexpr (ALIGN_EPI) { if (wr == 0) PG8_BAR; }
        if constexpr (!Epi::AFTER_DRAIN) { if constexpr (Epi::HAS_PRE) E(acc, cur, wr, wc, fr, fq, epre); else E(acc, cur, wr, wc, fr, fq); S.done(cur); }
        if (!has_next) break;
#pragma unroll
        for (int a = 0; a < 2; ++a)
#pragma unroll
            for (int b = 0; b < 2; ++b)
#pragma unroll
                for (int m = 0; m < 4; ++m)
#pragma unroll
                    for (int n = 0; n < 2; ++n) acc[a][b][m][n] = (f32x4){0.f, 0.f, 0.f, 0.f};
        cur = nxt; cA = nA; cB = nB; ++ui;
        if constexpr (ALIGN_EPI) { if (wr == 1) PG8_BAR; }
    }
    PG8_WAIT_V(0);
    if constexpr (!ALIGN_EPI) { if (wr == 0) PG8_BAR; }
    PG8_BAR;
    if constexpr (Epi::AFTER_DRAIN) { E.fused(acc, cur, wr, wc, fr, fq, lds, wid, lane); S.done(cur); }
#undef PG8_SA
#undef PG8_SB
#undef PG8_STAGE
#undef PG8_LDA
#undef PG8_LDB
#undef PG8_MMA
#undef PG8_WAIT_V
#undef PG8_WAIT_L
#undef PG8_BAR
#undef PG8_SCHED
}
}
#define LAS __attribute__((address_space(3)))
typedef unsigned short bf16;
typedef unsigned v4u __attribute__((ext_vector_type(4)));
typedef float f32x4 __attribute__((ext_vector_type(4)));
#define LDS_WAIT() asm volatile("s_waitcnt lgkmcnt(0)" ::: "memory")

constexpr int NWAVES = 8, NTHREADS = 512;
constexpr int BATCH = 2, SEQ = 16384, M = BATCH * SEQ, D = 1024, FF = 2816, NPROJ = 2304, DEPTH = 4;
constexpr int P_AQ = 0, P_AK = 256, P_AV = 384, P_BU = 512, P_CQ = 768, P_CK = 1024, P_CV = 1280, P_DQ = 1536, P_DK = 1792, P_DV = 2048;
constexpr int S5L = 256, NCH = SEQ / S5L;
constexpr size_t MiB = 1u << 20;
constexpr size_t WS_W = 4 * MiB, W_LAYER = 40 * MiB;
constexpr size_t WO_1 = 0, WO_2 = 11 * MiB, WO_3 = 33 * MiB / 2, WO_GLU = 21 * MiB, WO_OUT = 43 * MiB / 2, WO_4 = 47 * MiB / 2, WO_5 = 69 * MiB / 2;
constexpr size_t WS_XB = 164 * MiB, WS_MIX = 228 * MiB, WS_H = 292 * MiB, WS_P = WS_H, WS_G = WS_H + 144 * MiB;
constexpr size_t WS_SEND = 468 * MiB, WS_SSQ = 476 * MiB, WS_SPREP = 478 * MiB, WS_END = 512 * MiB;
constexpr size_t WS_CP0 = 452 * MiB, WS_CP1 = 480 * MiB, WS_CP2 = 496 * MiB, WS_CL = 470 * MiB;
constexpr int SPREP_STRIDE = 2560;
constexpr int LDS_BYTES = 147456;
#ifndef REP_MIX1
#define REP_MIX1 1
#endif
#ifndef REP_MIX2
#define REP_MIX2 1
#endif
#ifndef REP_G1
#define REP_G1 1
#endif

__device__ __forceinline__ unsigned f2bf(float f) { unsigned u = __builtin_bit_cast(unsigned, f); return (u + 0x7fffu + ((u >> 16) & 1u)) >> 16; }
__device__ __forceinline__ unsigned pk2(float lo, float hi) { return f2bf(lo) | (f2bf(hi) << 16); }
__device__ __forceinline__ float bf_lo(unsigned w) { return __builtin_bit_cast(float, w << 16); }
__device__ __forceinline__ float bf_hi(unsigned w) { return __builtin_bit_cast(float, w & 0xffff0000u); }
__device__ __forceinline__ float wave_sum(float v) {
#pragma unroll
    for (int o = 1; o < 64; o <<= 1) v += __shfl_xor(v, o);
    return v;
}

struct Args { const float* in[22]; float* out; unsigned char* ws; };

__device__ __forceinline__ void transpose_item(const float* W, int K, int N, bf16* WT, int nrow0, int col0, int k0, const float* gain, LAS float* scr, int lane, bool f16) {
    float wv[32];
#pragma unroll
    for (int i = 0; i < 32; ++i) { const int kk = 2 * i + (lane >> 5); wv[i] = W[(size_t)(k0 + kk) * N + col0 + (lane & 31)]; }
#pragma unroll
    for (int i = 0; i < 32; ++i) { const int kk = 2 * i + (lane >> 5); float w = wv[i]; if (gain) w *= gain[k0 + kk]; scr[kk * 33 + (lane & 31)] = w; }
    LDS_WAIT();
    const int c = lane & 7;
#pragma unroll
    for (int j = 0; j < 4; ++j) { const int n = (lane >> 3) + 8 * j; const LAS float* s = scr + (8 * c) * 33 + n;
        v4u o;
        if (f16) {
#define W8(v) __builtin_bit_cast(float, f2bf(v) << 16)
            o.x = pg8::pk_f16(W8(s[0 * 33]), W8(s[1 * 33])); o.y = pg8::pk_f16(W8(s[2 * 33]), W8(s[3 * 33])); o.z = pg8::pk_f16(W8(s[4 * 33]), W8(s[5 * 33])); o.w = pg8::pk_f16(W8(s[6 * 33]), W8(s[7 * 33]));
#undef W8
        }
        else { o.x = pk2(s[0 * 33], s[1 * 33]); o.y = pk2(s[2 * 33], s[3 * 33]); o.z = pk2(s[4 * 33], s[5 * 33]); o.w = pk2(s[6 * 33], s[7 * 33]); }
        *(v4u*)(WT + (size_t)(nrow0 + n) * K + k0 + 8 * c) = o; }
    LDS_WAIT();
}
__device__ __forceinline__ void transpose_mat(const float* W, int K, int N, bf16* WT, int mode, const float* gain, LAS float* scr, int item, int lane) {
    const int nblk = N / 32, kb = item / nblk, nb = item % nblk, n0 = 32 * nb;
    int col0 = n0;
    if (mode == 1) { const int pn = n0 >> 8, bj = (n0 >> 7) & 1, r0 = n0 & 127; col0 = bj * FF + 128 * pn + r0; }
    else if (mode == 2) { const int pn = n0 >> 8, bj = (n0 >> 7) & 1, wc = (n0 >> 5) & 3; col0 = 256 * pn + 64 * wc + 32 * bj; }
    transpose_item(W, K, N, WT, n0, col0, 64 * kb, gain, scr, lane, RESID_F16 && mode != 0);
}

__device__ __forceinline__ void sincos_d(double th, double& s, double& c) {
    const double k = __builtin_rint(th * 0.63661977236758134308);
    double r = __builtin_fma(-k, 1.57079632679489655800e+00, th);
    r = __builtin_fma(-k, 6.12323399573676603587e-17, r);
    const double r2 = r * r;
    double sp = -1.0 / 1307674368000.0; sp = sp * r2 + 1.0 / 6227020800.0; sp = sp * r2 - 1.0 / 39916800.0; sp = sp * r2 + 1.0 / 362880.0; sp = sp * r2 - 1.0 / 5040.0; sp = sp * r2 + 1.0 / 120.0; sp = sp * r2 - 1.0 / 6.0; sp = sp * r2 + 1.0;
    const double sr = sp * r;
    double cp = 1.0 / 20922789888000.0; cp = cp * r2 - 1.0 / 87178291200.0; cp = cp * r2 + 1.0 / 479001600.0; cp = cp * r2 - 1.0 / 3628800.0; cp = cp * r2 + 1.0 / 40320.0; cp = cp * r2 - 1.0 / 720.0; cp = cp * r2 + 1.0 / 24.0; cp = cp * r2 - 0.5; cp = cp * r2 + 1.0;
    const int q = ((int)k) & 3;
    s = (q == 0) ? sr : (q == 1) ? cp : (q == 2) ? -sr : -cp;
    c = (q == 0) ? cp : (q == 1) ? -sr : (q == 2) ? -cp : sr;
}

__device__ __forceinline__ void load_row64(const bf16* p, float (&q)[64]) {
    const v4u* p4 = (const v4u*)p;
#pragma unroll
    for (int c = 0; c < 8; ++c) { const v4u w = p4[c];
        q[8 * c + 0] = bf_lo(w.x); q[8 * c + 1] = bf_hi(w.x); q[8 * c + 2] = bf_lo(w.y); q[8 * c + 3] = bf_hi(w.y);
        q[8 * c + 4] = bf_lo(w.z); q[8 * c + 5] = bf_hi(w.z); q[8 * c + 6] = bf_lo(w.w); q[8 * c + 7] = bf_hi(w.w); }
}
__device__ __forceinline__ void attn_visit(const bf16* kp, const bf16* vp, float bias, const float (&q)[64], float (&o)[64], float& mx, float& l) {
    const v4u* k4 = (const v4u*)kp; const v4u* v4 = (const v4u*)vp;
    float s0 = 0.f, s1 = 0.f;
#pragma unroll
    for (int c = 0; c < 8; ++c) { const v4u w = k4[c];
        s0 += q[8 * c + 0] * bf_lo(w.x); s1 += q[8 * c + 1] * bf_hi(w.x); s0 += q[8 * c + 2] * bf_lo(w.y); s1 += q[8 * c + 3] * bf_hi(w.y);
        s0 += q[8 * c + 4] * bf_lo(w.z); s1 += q[8 * c + 5] * bf_hi(w.z); s0 += q[8 * c + 6] * bf_lo(w.w); s1 += q[8 * c + 7] * bf_hi(w.w); }
    const float s = (s0 + s1) * 0.125f + bias;
    const float mn = fmaxf(mx, s), corr = __expf(mx - mn), p = __expf(s - mn);
    l = l * corr + p; mx = mn;
#pragma unroll
    for (int c = 0; c < 8; ++c) { const v4u w = v4[c];
        o[8 * c + 0] = o[8 * c + 0] * corr + p * bf_lo(w.x); o[8 * c + 1] = o[8 * c + 1] * corr + p * bf_hi(w.x);
        o[8 * c + 2] = o[8 * c + 2] * corr + p * bf_lo(w.y); o[8 * c + 3] = o[8 * c + 3] * corr + p * bf_hi(w.y);
        o[8 * c + 4] = o[8 * c + 4] * corr + p * bf_lo(w.z); o[8 * c + 5] = o[8 * c + 5] * corr + p * bf_hi(w.z);
        o[8 * c + 6] = o[8 * c + 6] * corr + p * bf_lo(w.w); o[8 * c + 7] = o[8 * c + 7] * corr + p * bf_hi(w.w); }
}
__device__ __forceinline__ void store_row64(bf16* p, const float (&o)[64], float sc) {
    v4u* p4 = (v4u*)p;
#pragma unroll
    for (int c = 0; c < 8; ++c) { v4u w; w.x = pk2(o[8 * c + 0] * sc, o[8 * c + 1] * sc); w.y = pk2(o[8 * c + 2] * sc, o[8 * c + 3] * sc); w.z = pk2(o[8 * c + 4] * sc, o[8 * c + 5] * sc); w.w = pk2(o[8 * c + 6] * sc, o[8 * c + 7] * sc); p4[c] = w; }
}

__device__ __forceinline__ void load_u16(const bf16* p, float (&u)[16]) {
    const v4u* p4 = (const v4u*)p;
#pragma unroll
    for (int c = 0; c < 2; ++c) { const v4u w = p4[c];
        u[8 * c + 0] = bf_lo(w.x); u[8 * c + 1] = bf_hi(w.x); u[8 * c + 2] = bf_lo(w.y); u[8 * c + 3] = bf_hi(w.y);
        u[8 * c + 4] = bf_lo(w.z); u[8 * c + 5] = bf_hi(w.z); u[8 * c + 6] = bf_lo(w.w); u[8 * c + 7] = bf_hi(w.w); }
}
__device__ __forceinline__ float gelu_tanh(float v) { const float z = 0.7978845608028654f * (v + 0.044715f * v * v * v); return v * __builtin_amdgcn_rcpf(1.0f + __expf(-2.0f * z)); }

typedef float f32x16 __attribute__((ext_vector_type(16)));
typedef short bf16x8 __attribute__((ext_vector_type(8)));
typedef unsigned long long u64x2 __attribute__((ext_vector_type(2)));
typedef __bf16 bf16x2_t __attribute__((ext_vector_type(2)));
typedef float f32x2_t __attribute__((ext_vector_type(2)));
#define MFMA32(a, b, c) __builtin_amdgcn_mfma_f32_32x32x16_bf16((a), (b), (c), 0, 0, 0)
constexpr int VSTR = 36;
constexpr float LOG2E = 1.4426950408889634f;
__device__ __forceinline__ unsigned cvtpk(float lo, float hi) { f32x2_t v = {lo, hi}; bf16x2_t b = __builtin_convertvector(v, bf16x2_t); return __builtin_bit_cast(unsigned, b); }
__device__ __forceinline__ float wave_max(float v) {
#pragma unroll
    for (int o = 1; o < 64; o <<= 1) v = fmaxf(v, __shfl_xor(v, o));
    return v;
}
__device__ __forceinline__ void attn_first(const bf16* Pb, int kcol, int vcol, int kbase, int kstride, int r, int h, v4u (&kn)[4], v4u (&vn)[4]) {
    const int lr = (r + 32 * h) >> 3, pc = (r + 32 * h) & 7;
    const unsigned char* Pk = (const unsigned char*)(Pb + kcol); const unsigned char* Pv = (const unsigned char*)(Pb + vcol);
#pragma unroll
    for (int i = 0; i < 4; ++i) { const int kt = kbase + kstride * (lr + 8 * i); const unsigned off = (unsigned)min(max(kt, 0), SEQ - 1) * (unsigned)(NPROJ * 2) + (unsigned)(16 * pc);
        kn[i] = *(const v4u*)(Pk + off); vn[i] = *(const v4u*)(Pv + off); }
}
template <int MODE>
__device__ __forceinline__ void attn_pass(const bf16* Pb, int kcol, int vcol, const bf16x8 (&qf)[4], int q_tok, int kbase, int kstride, int cstride, int nchunks, int maxd,
                                          float c2, float slope2, float negB2, const float* rb, int wr0, int wc0, unsigned char* vt, int r, int h, f32x16 (&o)[2], float& lsum,
                                          v4u (&kn)[4], v4u (&vn)[4], int nkcol, int nvcol) {
    const int lr = (r + 32 * h) >> 3, pc = (r + 32 * h) & 7, lane31 = r;
    const int dlo = max(-maxd, -q_tok); const unsigned dspan = (unsigned)(min(maxd, SEQ - 1 - q_tok) - dlo);
    const unsigned vt_lds = (unsigned)(size_t)(LAS unsigned char*)vt;
    unsigned char* kst = vt + 6656;
    const unsigned char* Pk = (const unsigned char*)(Pb + kcol); const unsigned char* Pv = (const unsigned char*)(Pb + vcol);
    for (int c = 0; c < nchunks; ++c) {
#pragma unroll
        for (int i = 0; i < 4; ++i) {
            *(v4u*)(kst + (lr + 8 * i) * 144 + 16 * pc) = kn[i];
            *(v4u*)(vt + (lr + 8 * i) * 144 + 16 * pc) = vn[i];
        }
        asm volatile("" ::: "memory");
        {
            const bool lastc = (c + 1 == nchunks);
            const unsigned char* Lk = (const unsigned char*)(Pb + (lastc ? nkcol : kcol)); const unsigned char* Lv = (const unsigned char*)(Pb + (lastc ? nvcol : vcol));
            const int cn = lastc ? 0 : c + 1;
#pragma unroll
            for (int i = 0; i < 4; ++i) { const int kt = kbase + cstride * cn + kstride * (lr + 8 * i); const unsigned off = (unsigned)min(max(kt, 0), SEQ - 1) * (unsigned)(NPROJ * 2) + (unsigned)(16 * pc);
                kn[i] = *(const v4u*)(Lk + off); vn[i] = *(const v4u*)(Lv + off); }
        }
        f32x16 s;
#pragma unroll
        for (int i = 0; i < 16; ++i) s[i] = 0.f;
#pragma unroll
        for (int ks = 0; ks < 4; ++ks) s = MFMA32(*(const bf16x8*)(kst + r * 144 + 32 * ks + 16 * h), qf[ks], s);
        asm volatile("" ::: "memory");
        const int k0 = kbase + cstride * c + kstride * (4 * h);
        const int dl0 = k0 - q_tok;
        float p[16];
#pragma unroll
        for (int i = 0; i < 16; ++i) {
            const int k = k0 + kstride * ((i & 3) + 8 * (i >> 2));
            float pv;
            if (MODE == 0) {
                const int dl = dl0 + kstride * ((i & 3) + 8 * (i >> 2));
                const bool valid = (unsigned)(dl - dlo) <= dspan;
                const float s2 = fmaf(__builtin_fabsf((float)dl), -slope2, fmaf(s[i], c2, negB2));
                pv = valid ? __builtin_amdgcn_exp2f(s2) : 0.f;
            } else {
                const int kcl = k & 63, krw = k >> 6;
                const bool valid = ((unsigned)(kcl - wc0) < 16u) && ((unsigned)(krw - wr0) < 8u);
                int idx = (krw - (q_tok >> 6) + 7) * 31 + (kcl - (q_tok & 63) + 15);
                idx = min(max(idx, 0), 15 * 31 - 1);
                const float s2 = fmaf(s[i], c2, fmaf(rb[idx], LOG2E, negB2));
                pv = valid ? __builtin_amdgcn_exp2f(s2) : 0.f;
            }
            p[i] = pv; lsum += pv;
        }
        bf16x8 pf[2];
#pragma unroll
        for (int sx = 0; sx < 2; ++sx) { v4u w; w.x = cvtpk(p[8 * sx + 0], p[8 * sx + 1]); w.y = cvtpk(p[8 * sx + 2], p[8 * sx + 3]); w.z = cvtpk(p[8 * sx + 4], p[8 * sx + 5]); w.w = cvtpk(p[8 * sx + 6], p[8 * sx + 7]);
            pf[sx] = __builtin_bit_cast(bf16x8, w); }
        asm volatile("s_waitcnt lgkmcnt(0)" ::: "memory");
#pragma unroll
        for (int dt = 0; dt < 2; ++dt)
#pragma unroll
            for (int sx = 0; sx < 2; ++sx) {
                const unsigned a0 = vt_lds + (unsigned)((16 * sx + 4 * h + ((lane31 & 15) >> 2)) * 144 + 64 * dt + 32 * ((lane31 >> 4) & 1) + 8 * (lane31 & 3));
                typedef short v4i16_t __attribute__((ext_vector_type(4)));
                const v4i16_t t0 = __builtin_amdgcn_ds_read_tr16_b64_v4i16((LAS v4i16_t*)(size_t)a0), t1 = __builtin_amdgcn_ds_read_tr16_b64_v4i16((LAS v4i16_t*)(size_t)(a0 + 8 * 144));
                bf16x8 av; av[0] = t0[0]; av[1] = t0[1]; av[2] = t0[2]; av[3] = t0[3]; av[4] = t1[0]; av[5] = t1[1]; av[6] = t1[2]; av[7] = t1[3];
                o[dt] = MFMA32(av, pf[sx], o[dt]);
            }
        asm volatile("s_waitcnt lgkmcnt(0)" ::: "memory");
    }
}
__device__ __forceinline__ void attn_store(bf16* orow, const f32x16 (&o)[2], float sc, int h) {
#pragma unroll
    for (int dt = 0; dt < 2; ++dt)
#pragma unroll
        for (int g = 0; g < 4; ++g) {
            const unsigned lo = cvtpk(o[dt][4 * g + 0] * sc, o[dt][4 * g + 1] * sc), hi = cvtpk(o[dt][4 * g + 2] * sc, o[dt][4 * g + 3] * sc);
            *(unsigned long long*)(orow + 32 * dt + 8 * g + 4 * h) = (unsigned long long)lo | ((unsigned long long)hi << 32);
        }
}

typedef float f32x4a __attribute__((ext_vector_type(4)));
#define MFMA16(a, b, c) __builtin_amdgcn_mfma_f32_16x16x32_bf16((a), (b), (c), 0, 0, 0)
constexpr int XSTR = 168;
__device__ __forceinline__ void s5_bu_tile(const v4u uav, const bf16x8 (&bm)[4], int r, int h, f32x16& re0, f32x16& re1, f32x16& im0, f32x16& im1) {
    const bf16x8 ua = __builtin_bit_cast(bf16x8, uav);
    f32x16 z;
#pragma unroll
    for (int i = 0; i < 16; ++i) z[i] = 0.f;
    re0 = MFMA32(ua, bm[0], z); re1 = MFMA32(ua, bm[1], z); im0 = MFMA32(ua, bm[2], z); im1 = MFMA32(ua, bm[3], z);
    asm volatile("s_nop 15\n\ts_nop 3" : "+v"(re0), "+v"(re1), "+v"(im0), "+v"(im1));
#pragma unroll
    for (int i = 0; i < 16; ++i) {
        asm volatile("s_nop 1\n\tv_permlane32_swap_b32 %0, %1" : "+v"(re0[i]), "+v"(re1[i]));
        asm volatile("s_nop 1\n\tv_permlane32_swap_b32 %0, %1" : "+v"(im0[i]), "+v"(im1[i]));
    }
}
template <bool REV, bool WRITE>
__device__ __forceinline__ void s5_scan_tile(const f32x16& re0, const f32x16& re1, const f32x16& im0, const f32x16& im1, float ar, float ai, float& xr, float& xi, unsigned short* xs, int p) {
#pragma unroll
    for (int q = 0; q < 32; ++q) {
        const int t = REV ? 31 - q : q;
        const int g8 = t >> 3, w = (t >> 2) & 1, j = t & 3, i = 4 * g8 + j;
        const float bur = w ? re1[i] : re0[i], bui = w ? im1[i] : im0[i];
        const float nr = fmaf(ar, xr, fmaf(-ai, xi, bur)), ni = fmaf(ar, xi, fmaf(ai, xr, bui));
        xr = nr; xi = ni;
        if (WRITE) { const unsigned pk = cvtpk(xr, xi); xs[t * XSTR + p] = (unsigned short)(pk & 0xffffu); xs[t * XSTR + 64 + p] = (unsigned short)(pk >> 16); }
    }
}


#define XB_TMO      128
#define XB_XCNT(j)  (256  + 64 * (j))
#define XB_XSUB(j)  (1280 + 64 * (j))
#define XB_XGEN(j)  (2304 + 64 * (j))
#define XB_TOP      3328
#define XB_TOPGEN   3392
#define XCD_BAR_WORDS 3456
#define XB_SPIN_CAP (1u << 18)

__device__ __forceinline__ unsigned xb_ld(unsigned* p)              { return __hip_atomic_load(p, __ATOMIC_RELAXED, __HIP_MEMORY_SCOPE_AGENT); }
__device__ __forceinline__ unsigned xb_add(unsigned* p, unsigned v) { return __hip_atomic_fetch_add(p, v, __ATOMIC_RELAXED, __HIP_MEMORY_SCOPE_AGENT); }
__device__ __forceinline__ unsigned xb_xcc_id() { return (unsigned)__builtin_amdgcn_s_getreg((3 << 11) | 20) & 0xFu; }
#define XB_SPIN(cond, bar) do { unsigned _sp = 0; while (cond) { __builtin_amdgcn_s_sleep(1); \
    if ((++_sp & 255u) == 0u) { if (xb_ld(&(bar)[XB_TMO])) break; if (_sp > XB_SPIN_CAP) { atomicAdd(&(bar)[XB_TMO], 1u); break; } } } } while (0)

struct XcdBarrier {
    unsigned* bar; unsigned x;
    volatile LAS unsigned* st;
};

__device__ __forceinline__ XcdBarrier xcd_barrier_post(unsigned* bar, volatile LAS unsigned* st) {
    XcdBarrier b; b.bar = bar; b.x = xb_xcc_id(); b.st = st;
    if (threadIdx.x == 0) (void)xb_add(&bar[XB_XCNT(b.x)], 1u);
    return b;
}
__device__ __forceinline__ void xcd_barrier_complete(unsigned* bar, unsigned x, unsigned& nloc, unsigned& nx) {
    const unsigned G = gridDim.x * gridDim.y * gridDim.z;
    unsigned sum, cnt, mine, sp = 0u;
    for (;;) {
        sum = 0u; cnt = 0u; mine = 0u;
#pragma unroll
        for (unsigned j = 0; j < 16; ++j) { const unsigned c = xb_ld(&bar[XB_XCNT(j)]); sum += c; cnt += (c > 0u) ? 1u : 0u; mine = (j == x) ? c : mine; }
        if (sum == G) break;
        __builtin_amdgcn_s_sleep(1);
        if ((++sp & 255u) == 0u) { if (xb_ld(&bar[XB_TMO])) break; if (sp > XB_SPIN_CAP) { atomicAdd(&bar[XB_TMO], 1u); break; } }
    }
    nloc = mine > 0u ? mine : 1u; nx = cnt > 0u ? cnt : 1u;
}

__device__ __forceinline__ void xcd_barrier(const XcdBarrier& b) {
    asm volatile("s_waitcnt vmcnt(0)" ::: "memory");
    __syncthreads();
    if (threadIdx.x == 0) {
        unsigned* bar = b.bar;
        __builtin_amdgcn_s_waitcnt(0);
        unsigned nloc = b.st[0], nx = b.st[1];
        if (nloc == 0u) { xcd_barrier_complete(bar, b.x, nloc, nx); b.st[0] = nloc; b.st[1] = nx; }
        const unsigned old = xb_add(&bar[XB_XSUB(b.x)], 1u);
        const unsigned gen = old / nloc;
        if (old + 1u == (gen + 1u) * nloc) {
            __builtin_amdgcn_fence(__ATOMIC_RELEASE, "agent");
            asm volatile("s_waitcnt vmcnt(0)" ::: "memory");
            const unsigned og = xb_add(&bar[XB_TOP], 1u);
            const unsigned tg = og / nx;
            if (og + 1u == (tg + 1u) * nx) xb_add(&bar[XB_TOPGEN], 1u);
            else XB_SPIN(xb_ld(&bar[XB_TOPGEN]) == tg, bar);
            __builtin_amdgcn_fence(__ATOMIC_ACQUIRE, "agent");
            xb_add(&bar[XB_XGEN(b.x)], 1u);
            asm volatile("s_waitcnt vmcnt(0)" ::: "memory");
        } else {
            XB_SPIN(xb_ld(&bar[XB_XGEN(b.x)]) == gen, bar);
            __builtin_amdgcn_fence(__ATOMIC_ACQUIRE, "agent");
            asm volatile("s_waitcnt vmcnt(0)" ::: "memory");
        }
    }
    __syncthreads();
}

__global__ void __launch_bounds__(NTHREADS, 2) hybrid_fwd(Args args) {
    extern __shared__ __attribute__((aligned(16))) unsigned char lds[];
    cg::grid_group grid = cg::this_grid();
    LAS unsigned char* ldsl = (LAS unsigned char*)lds;
    const int tid = threadIdx.x, lane = tid & 63, wave = __builtin_amdgcn_readfirstlane(tid >> 6);
    const int G = gridDim.x, bx = blockIdx.x;
    const int gw = bx * NWAVES + wave, NGW = G * NWAVES;
    unsigned char* ws = args.ws;
    const float* x_in = args.in[0];
    float* out = args.out;
    bf16* XB = (bf16*)(ws + WS_XB); bf16* MIX = (bf16*)(ws + WS_MIX); bf16* HB = (bf16*)(ws + WS_H); bf16* PB = (bf16*)(ws + WS_P); bf16* GB = (bf16*)(ws + WS_G);
    float* SEND = (float*)(ws + WS_SEND); float* SSQ = (float*)(ws + WS_SSQ); float* SPREP = (float*)(ws + WS_SPREP);

    volatile LAS unsigned* xb_st = (volatile LAS unsigned*)(ldsl + 131072 + 1024);
    if (tid < 2) xb_st[tid] = 0u;
    if (bx == 0) for (int i = tid; i < XCD_BAR_WORDS; i += NTHREADS) ((unsigned*)ws)[i] = 0u;
    __syncthreads();
    {
        LAS float* scr = (LAS float*)(ldsl + wave * 16384);
        constexpr int I1 = (D / 64) * (2 * FF / 32), I2 = (FF / 64) * (D / 32), I3 = (D / 64) * (NPROJ / 32), IG = (256 / 64) * (256 / 32), IO = (D / 64) * (D / 32);
        constexpr int IL = 2 * I1 + 2 * I2 + I3 + IG + IO;
        for (int it = gw; it < DEPTH * IL; it += NGW) {
            const int l = it / IL; int r = it % IL;
            bf16* wl = (bf16*)(ws + WS_W + (size_t)l * W_LAYER);
            if (r < I1) { transpose_mat(args.in[2] + (size_t)l * D * 2 * FF, D, 2 * FF, (bf16*)((unsigned char*)wl + WO_1), 1, args.in[1] + l * D, scr, r, lane); continue; } r -= I1;
            if (r < I2) { transpose_mat(args.in[3] + (size_t)l * FF * D, FF, D, (bf16*)((unsigned char*)wl + WO_2), 0, nullptr, scr, r, lane); continue; } r -= I2;
            if (r < I3) { transpose_mat(args.in[5] + (size_t)l * D * NPROJ, D, NPROJ, (bf16*)((unsigned char*)wl + WO_3), 2, args.in[4] + l * D, scr, r, lane); continue; } r -= I3;
            if (r < IG) { transpose_mat(args.in[16] + (size_t)l * 256 * 256, 256, 256, (bf16*)((unsigned char*)wl + WO_GLU), 0, nullptr, scr, r, lane); continue; } r -= IG;
            if (r < IO) { transpose_mat(args.in[18] + (size_t)l * D * D, D, D, (bf16*)((unsigned char*)wl + WO_OUT), 0, nullptr, scr, r, lane); continue; } r -= IO;
            if (r < I1) { transpose_mat(args.in[20] + (size_t)l * D * 2 * FF, D, 2 * FF, (bf16*)((unsigned char*)wl + WO_4), 1, args.in[19] + l * D, scr, r, lane); continue; } r -= I1;
            transpose_mat(args.in[21] + (size_t)l * FF * D, FF, D, (bf16*)((unsigned char*)wl + WO_5), 0, nullptr, scr, r, lane);
        }
        for (int m = gw; m < M; m += NGW) {
            const f32x4* xr = (const f32x4*)(x_in + (size_t)m * D) + lane;
            unsigned long long* o8 = (unsigned long long*)(XB + (size_t)m * D) + lane;
            float s = 0.f;
#pragma unroll
            for (int j = 0; j < 4; ++j) { const f32x4 v = xr[64 * j]; s += (v[0] * v[0] + v[1] * v[1]) + (v[2] * v[2] + v[3] * v[3]);
                o8[64 * j] = RESID_F16 ? ((unsigned long long)pg8::pk_f16r(v[0], v[1]) | ((unsigned long long)pg8::pk_f16r(v[2], v[3]) << 32)) : ((unsigned long long)pk2(v[0], v[1]) | ((unsigned long long)pk2(v[2], v[3]) << 32)); }
            s = wave_sum(s);
            if (lane < 16) SSQ[(size_t)m * 16 + lane] = (lane == 0) ? s : 0.f;
        }
        {
            int tid0 = wave * 64 + fresh_lane_id(); asm volatile("" : "+v"(tid0));
            const int i = bx * NTHREADS + tid0;
            if (i < DEPTH * 2 * 16 * 64) {
                const int p = i & 63, ldg = i >> 6;
                const double step = exp((double)args.in[10][ldg]);
                const double lr = (double)args.in[8][i], li = (double)args.in[9][i];
                const double mag = exp(lr * step);
                double sn, cs; sincos_d(li * step, sn, cs);
                const double ar = mag * cs, ai = mag * sn;
                const double den = lr * lr + li * li, xr = ar - 1.0;
                const double cr = (xr * lr + ai * li) / den, ci = (ai * lr - xr * li) / den;
                float* prm = SPREP + (size_t)ldg * SPREP_STRIDE;
                prm[p] = (float)ar; prm[64 + p] = (float)ai;
                double pr = ar, pi = ai;
#pragma unroll
                for (int k = 0; k < 8; ++k) { const double nr = pr * pr - pi * pi, ni = 2.0 * pr * pi; pr = nr; pi = ni; }
                prm[128 + p] = (float)pr; prm[192 + p] = (float)pi;
                const float* bre = args.in[11] + (size_t)i * 16; const float* bim = args.in[12] + (size_t)i * 16;
                bf16* bbf = (bf16*)(prm + 256);
                bf16* cmf = (bf16*)(prm + 1280);
                const float crf = (float)cr, cif = (float)ci;
#pragma unroll 1
                for (int c = 0; c < 16; ++c) { const float br = bre[c], bi = bim[c];
                    bbf[p * 16 + c] = (bf16)f2bf(crf * br - cif * bi); bbf[(64 + p) * 16 + c] = (bf16)f2bf(crf * bi + cif * br);
                    cmf[c * 128 + p] = (bf16)f2bf(args.in[13][((size_t)ldg * 16 + c) * 64 + p]); cmf[c * 128 + 64 + p] = (bf16)f2bf(-args.in[14][((size_t)ldg * 16 + c) * 64 + p]); }
            }
        }
    }
    grid.sync();
    const XcdBarrier xbar = xcd_barrier_post((unsigned*)ws, xb_st);

#pragma clang loop unroll(disable)
    for (int layer = 0; layer < DEPTH; ++layer) {
        unsigned char* wl = ws + WS_W + (size_t)layer * W_LAYER;
        float* ssq0 = SSQ; float* ssq1 = SSQ; float* ssq2 = SSQ; float* ssq3 = SSQ;
        for (int rep = 0; rep < REP_G1; ++rep)
        { pg8::Gemm g{XB, (const bf16*)(wl + WO_1), M, 2 * FF, D}; pg8::StaticOrder S; S.init(M, 2 * FF, G, bx);
          pg8::EpiSwiGLU E{HB, ssq0};
          pg8::gemm_phase<pg8::EpiSwiGLU, pg8::StaticOrder, true, true, (RESID_F16 != 0)>(ldsl, g, S, E, wave); }
        xcd_barrier(xbar);
        { pg8::Gemm g{HB, (const bf16*)(wl + WO_2), M, D, FF}; pg8::StaticOrder S; S.init(M, D, G, bx);
          pg8::EpiRes E{nullptr, XB, ssq1, 0.5f};
          pg8::gemm_phase<pg8::EpiRes, pg8::StaticOrder, true, true>(ldsl, g, S, E, wave); }
        xcd_barrier(xbar);
        { pg8::Gemm g{XB, (const bf16*)(wl + WO_3), M, NPROJ, D}; pg8::StaticOrder S; S.init(M, NPROJ, G, bx);
          pg8::EpiInProj E{PB, ssq1, args.in[6] + layer * 384};
          pg8::gemm_phase<pg8::EpiInProj, pg8::StaticOrder, true, true, (RESID_F16 != 0)>(ldsl, g, S, E, wave); }
        xcd_barrier(xbar);
#ifndef NO_MIX1
        {
            int lane_ = fresh_lane_id(); asm volatile("" : "+v"(lane_)); const int lane = lane_;
            constexpr int N_ATT = (M / 32) * 4;
            constexpr int N_TYPES = 5;
            constexpr int N_S5 = BATCH * NCH * 16 * 2;
            unsigned char* vt = lds + wave * 12288;
            float* rbl = (float*)(vt + 4608);
            const int r = lane & 31, h = lane >> 5;
            const float* qkg = args.in[6] + layer * 384;
            float Bg0, Bg1, Bg2, Bd0, Bd1, Bd2, Bd3;
            {
                const float a0 = wave_max(fabsf(qkg[0 * 64 + lane])), a1 = wave_max(fabsf(qkg[1 * 64 + lane])), a2 = wave_max(fabsf(qkg[2 * 64 + lane]));
                const float a3 = wave_max(fabsf(qkg[3 * 64 + lane])), a4 = wave_max(fabsf(qkg[4 * 64 + lane])), a5 = wave_max(fabsf(qkg[5 * 64 + lane]));
                Bg0 = 8.0f * a0 * a1; Bg1 = 8.0f * a2 * a3; Bg2 = 8.0f * a4 * a5;
                const float* rb0 = args.in[17] + (size_t)(layer * 4) * 15 * 31;
                float m0 = -1e30f, m1 = -1e30f, m2 = -1e30f, m3 = -1e30f;
                for (int i = lane; i < 15 * 31; i += 64) { m0 = fmaxf(m0, rb0[i]); m1 = fmaxf(m1, rb0[465 + i]); m2 = fmaxf(m2, rb0[930 + i]); m3 = fmaxf(m3, rb0[1395 + i]); }
                Bd0 = fmaxf(wave_max(m0), 0.f); Bd1 = fmaxf(wave_max(m1), 0.f); Bd2 = fmaxf(wave_max(m2), 0.f); Bd3 = fmaxf(wave_max(m3), 0.f);
            }
            const int vwv = (((G & 7) == 0) ? (bx & 7) * (G >> 3) + (bx >> 3) : bx) * NWAVES + wave;
            constexpr int N_ALL = N_TYPES * N_ATT + N_S5;
            const int per_att = (N_ATT + NGW - 1) / NGW, per_s5 = (N_S5 + NGW - 1) / NGW, per_all = N_TYPES * per_att + per_s5;
            for (int rep = 0; rep < REP_MIX1; ++rep)
            for (int ii = 0; ii < per_all; ++ii) {
                int it;
                if (ii < N_TYPES * per_att) { const int ty = ii / per_att, j = vwv * per_att + ii % per_att; if (j >= N_ATT) continue; it = ty * N_ATT + j; }
                else { const int j = vwv * per_s5 + (ii - N_TYPES * per_att); if (j >= N_S5) continue; it = N_TYPES * N_ATT + j; }
                if (it < N_TYPES * N_ATT) {
                    const int type = it / N_ATT, ri = it % N_ATT, hd0 = ri & 3, tile = ri >> 2, b = tile >> 9, tl = tile & 511;
                    const bool paired = (per_att & 1) == 0;
                    if (paired && ((ii % per_att) & 1)) continue;
                    const int nh = paired ? 2 : 1;
                    const int gsel = (type == 0) ? 0 : (type == 4) ? 2 : 1;
                    const float Bt = (gsel == 0) ? Bg0 : (gsel == 1) ? Bg1 : Bg2;
                    const float c2 = 0.125f * LOG2E;
                    const bf16* Pb = PB + (size_t)b * SEQ * NPROJ;
                    v4u kvk[4], kvv[4];
                    if (type == 0) {
                        const int t0 = tl * 32, q_tok = t0 + r;
                        attn_first(Pb, P_AK + 64 * (hd0 >> 1), P_AV + 64 * (hd0 >> 1), t0 - 128, 1, r, h, kvk, kvv);
                        for (int hs = 0; hs < nh; ++hs) {
                            const int hd = hd0 + hs, hn = (hs + 1 < nh) ? hd + 1 : hd;
                            f32x16 o[2];
#pragma unroll
                            for (int i = 0; i < 16; ++i) { o[0][i] = 0.f; o[1][i] = 0.f; }
                            float lsum = 0.f; bf16x8 qf[4];
#pragma unroll
                            for (int ks = 0; ks < 4; ++ks) qf[ks] = __builtin_bit_cast(bf16x8, *(const v4u*)(Pb + (size_t)q_tok * NPROJ + P_AQ + 64 * hd + 16 * ks + 8 * h));
                            const float slope = exp2f(-(float)(hd + 1));
                            attn_pass<0>(Pb, P_AK + 64 * (hd >> 1), P_AV + 64 * (hd >> 1), qf, q_tok, t0 - 128, 1, 32, 9, 128, c2, slope * LOG2E, -Bt * LOG2E, nullptr, 0, 0, vt, r, h, o, lsum, kvk, kvv, P_AK + 64 * (hn >> 1), P_AV + 64 * (hn >> 1));
                            const float l = lsum + __shfl_xor(lsum, 32);
                            const float lse = Bt + __logf(l); const float gate = 1.0f / (1.0f + __expf(-(lse - args.in[7][layer * 4 + hd])));
                            attn_store(MIX + (size_t)(b * SEQ + q_tok) * D + 64 * hd, o, gate / l, h);
                        }
                    } else if (type < 4) {
                        const int dil = (type == 1) ? 1 : (type == 2) ? 4 : 16, lg = (type == 1) ? 0 : (type == 2) ? 2 : 4;
                        const int q0 = ((tl >> lg) << (lg + 5)) + (tl & (dil - 1)), q_tok = q0 + dil * r;
                        bf16* CP = (bf16*)(ws + ((type == 1) ? WS_CP0 : (type == 2) ? WS_CP1 : WS_CP2));
                        attn_first(Pb, P_CK + 64 * hd0, P_CV + 64 * hd0, q0 - 64 * dil, dil, r, h, kvk, kvv);
                        for (int hs = 0; hs < nh; ++hs) {
                            const int hd = hd0 + hs, hn = (hs + 1 < nh) ? hd + 1 : hd;
                            f32x16 o[2];
#pragma unroll
                            for (int i = 0; i < 16; ++i) { o[0][i] = 0.f; o[1][i] = 0.f; }
                            float lsum = 0.f; bf16x8 qf[4];
#pragma unroll
                            for (int ks = 0; ks < 4; ++ks) qf[ks] = __builtin_bit_cast(bf16x8, *(const v4u*)(Pb + (size_t)q_tok * NPROJ + P_CQ + 64 * hd + 16 * ks + 8 * h));
                            const float slope = exp2f(-(float)(hd + 5));
                            attn_pass<0>(Pb, P_CK + 64 * hd, P_CV + 64 * hd, qf, q_tok, q0 - 64 * dil, dil, 32 * dil, 5, 64 * dil, c2, slope * LOG2E, -Bt * LOG2E, nullptr, 0, 0, vt, r, h, o, lsum, kvk, kvv, P_CK + 64 * hn, P_CV + 64 * hn);
                            const float l = lsum + __shfl_xor(lsum, 32);
                            attn_store(CP + (size_t)(b * SEQ + q_tok) * 256 + 64 * hd, o, 1.0f, h);
                            if (h == 0) ((float*)(ws + WS_CL))[((size_t)(type - 1) * M + b * SEQ + q_tok) * 4 + hd] = l;
                        }
                    } else {
                        const int Rp = tl >> 2, jb = tl & 3;
                        const int qrow = 2 * Rp + (r >> 4), qc = 16 * jb + (r & 15), q_tok = qrow * 64 + qc;
                        const int wr0 = min(max(qrow - 4, 0), 256 - 8), wc0 = min(max(qc - 8, 0), 64 - 16);
                        const int wrmin = min(max(2 * Rp - 4, 0), 256 - 8), cs = min(max(16 * jb - 8, 0), 32);
                        attn_first(Pb, P_DK + 64 * hd0, P_DV + 64 * hd0, wrmin * 64 + cs, 1, r, h, kvk, kvv);
                        for (int hs = 0; hs < nh; ++hs) {
                            const int hd = hd0 + hs, hn = (hs + 1 < nh) ? hd + 1 : hd;
                            f32x16 o[2];
#pragma unroll
                            for (int i = 0; i < 16; ++i) { o[0][i] = 0.f; o[1][i] = 0.f; }
                            float lsum = 0.f; bf16x8 qf[4];
                            const float* rb = args.in[17] + (size_t)(layer * 4 + hd) * 15 * 31;
                            for (int i = lane; i < 15 * 31; i += 64) rbl[i] = rb[i];
                            const float B = Bt + ((hd == 0) ? Bd0 : (hd == 1) ? Bd1 : (hd == 2) ? Bd2 : Bd3);
#pragma unroll
                            for (int ks = 0; ks < 4; ++ks) qf[ks] = __builtin_bit_cast(bf16x8, *(const v4u*)(Pb + (size_t)q_tok * NPROJ + P_DQ + 64 * hd + 16 * ks + 8 * h));
                            asm volatile("s_waitcnt lgkmcnt(0)" ::: "memory");
                            attn_pass<1>(Pb, P_DK + 64 * hd, P_DV + 64 * hd, qf, q_tok, wrmin * 64 + cs, 1, 64, 9, 0, c2, 0.f, -B * LOG2E, rbl, wr0, wc0, vt, r, h, o, lsum, kvk, kvv, P_DK + 64 * hn, P_DV + 64 * hn);
                            const float l = lsum + __shfl_xor(lsum, 32);
                            attn_store(MIX + (size_t)(b * SEQ + q_tok) * D + 768 + 64 * hd, o, 1.0f / l, h);
                        }
                    }
                } else {
                    const int r5 = it - N_TYPES * N_ATT;
                    const int dir = r5 & 1, g = (r5 >> 1) & 15, c = (r5 >> 5) % NCH, b = (r5 >> 5) / NCH;
                    const float* prm = SPREP + (size_t)((layer * 2 + dir) * 16 + g) * SPREP_STRIDE;
                    const int p = r + 32 * h;
                    const float ar = prm[p], ai = prm[64 + p];
                    bf16x8 bm[4];
#pragma unroll
                    for (int j = 0; j < 4; ++j) bm[j] = __builtin_bit_cast(bf16x8, *(const v4u*)((const bf16*)(prm + 256) + (32 * j + r) * 16 + 8 * h));
                    float xr = 0.f, xi = 0.f;
                    const bf16* ub0 = PB + (size_t)(b * SEQ + c * S5L) * NPROJ + P_BU + 16 * g;
                    for (int tt = 0; tt < S5L / 32; ++tt) {
                        const int T = (dir == 0) ? tt : S5L / 32 - 1 - tt;
                        const v4u uc = *(const v4u*)(ub0 + (size_t)(32 * T + r) * NPROJ + 8 * h);
                        f32x16 re0, re1, im0, im1;
                        s5_bu_tile(uc, bm, r, h, re0, re1, im0, im1);
                        if (dir == 0) s5_scan_tile<false, false>(re0, re1, im0, im1, ar, ai, xr, xi, nullptr, p);
                        else s5_scan_tile<true, false>(re0, re1, im0, im1, ar, ai, xr, xi, nullptr, p);
                    }
                    float* dst = SEND + ((size_t)(((b * 2 + dir) * NCH + c) * 16 + g) * 64 + p) * 2;
                    dst[0] = xr; dst[1] = xi;
                }
            }
        }
#endif
        xcd_barrier(xbar);
#ifndef NO_MIX2
        {
            int lane_ = fresh_lane_id(); asm volatile("" : "+v"(lane_)); const int lane = lane_;
            unsigned short* xs = (unsigned short*)(lds + wave * 14848);
            float* sbuf = (float*)(lds + wave * 14848 + 10752);
            const int r = lane & 31, h = lane >> 5, p = r + 32 * h, cc = lane & 15, fq = lane >> 4;
            for (int rep = 0; rep < REP_MIX2; ++rep)
            for (int it = gw; it < BATCH * NCH * 16; it += NGW) {
                const int g = it & 15, c = (it >> 4) % NCH, b = (it >> 4) / NCH;
                const float* prm0 = SPREP + (size_t)((layer * 2 + 0) * 16 + g) * SPREP_STRIDE;
                const float* prm1 = SPREP + (size_t)((layer * 2 + 1) * 16 + g) * SPREP_STRIDE;
                const bf16* ub0 = PB + (size_t)(b * SEQ + c * S5L) * NPROJ + P_BU + 16 * g;
                float fr_ = 0.f, fi_ = 0.f, br_ = 0.f, bi_ = 0.f;
                {
                    const float alr = prm0[128 + p], ali = prm0[192 + p];
                    const float* sb = SEND + ((size_t)((b * 2 + 0) * NCH) * 16 + g) * 128 + p * 2;
                    typedef float f32x2c __attribute__((ext_vector_type(2)));
                    int j = 0;
                    for (; j + 8 <= c; j += 8) {
                        f32x2c e[8];
#pragma unroll
                        for (int k = 0; k < 8; ++k) e[k] = *(const f32x2c*)(sb + (size_t)(j + k) * 2048);
#pragma unroll
                        for (int k = 0; k < 8; ++k) { const float nr = alr * fr_ - ali * fi_ + e[k][0], ni = alr * fi_ + ali * fr_ + e[k][1]; fr_ = nr; fi_ = ni; }
                    }
                    for (; j < c; ++j) { const f32x2c e = *(const f32x2c*)(sb + (size_t)j * 2048); const float nr = alr * fr_ - ali * fi_ + e[0], ni = alr * fi_ + ali * fr_ + e[1]; fr_ = nr; fi_ = ni; }
                }
                {
                    const float alr = prm1[128 + p], ali = prm1[192 + p];
                    const float* sb = SEND + ((size_t)((b * 2 + 1) * NCH) * 16 + g) * 128 + p * 2;
                    typedef float f32x2c __attribute__((ext_vector_type(2)));
                    int j = NCH - 1;
                    for (; j - 8 >= c; j -= 8) {
                        f32x2c e[8];
#pragma unroll
                        for (int k = 0; k < 8; ++k) e[k] = *(const f32x2c*)(sb + (size_t)(j - k) * 2048);
#pragma unroll
                        for (int k = 0; k < 8; ++k) { const float nr = alr * br_ - ali * bi_ + e[k][0], ni = alr * bi_ + ali * br_ + e[k][1]; br_ = nr; bi_ = ni; }
                    }
                    for (; j > c; --j) { const f32x2c e = *(const f32x2c*)(sb + (size_t)j * 2048); const float nr = alr * br_ - ali * bi_ + e[0], ni = alr * bi_ + ali * br_ + e[1]; br_ = nr; bi_ = ni; }
                }
                const float ar0 = prm0[p], ai0 = prm0[64 + p], ar1 = prm1[p], ai1 = prm1[64 + p];
                bf16x8 bm0[4], bm1[4], cm0[4], cm1[4];
#pragma unroll
                for (int j = 0; j < 4; ++j) {
                    bm0[j] = __builtin_bit_cast(bf16x8, *(const v4u*)((const bf16*)(prm0 + 256) + (32 * j + r) * 16 + 8 * h));
                    bm1[j] = __builtin_bit_cast(bf16x8, *(const v4u*)((const bf16*)(prm1 + 256) + (32 * j + r) * 16 + 8 * h));
                    cm0[j] = __builtin_bit_cast(bf16x8, *(const v4u*)((const bf16*)(prm0 + 1280) + cc * 128 + 32 * j + 8 * fq));
                    cm1[j] = __builtin_bit_cast(bf16x8, *(const v4u*)((const bf16*)(prm1 + 1280) + cc * 128 + 32 * j + 8 * fq));
                }
                bf16x8 dg;
                { const unsigned db = f2bf(args.in[15][layer * 256 + 16 * g + cc]);
#pragma unroll
                  for (int j = 0; j < 8; ++j) dg[j] = (short)((8 * fq + j == cc) ? db : 0u); }
                const bf16* ul = ub0 + (size_t)r * NPROJ + 8 * h;
                { v4u z4 = {0u, 0u, 0u, 0u}; *(v4u*)(xs + r * XSTR + 144 + 8 * h) = z4; }
                {
                    v4u un = *(const v4u*)(ul + (size_t)(32 * (S5L / 32 - 1)) * NPROJ);
                    for (int T = S5L / 32 - 1; T >= 0; --T) {
                        sbuf[(T * 64 + p) * 2] = br_; sbuf[(T * 64 + p) * 2 + 1] = bi_;
                        if (T > 0) { const v4u uc = un; if (T > 1) un = *(const v4u*)(ul + (size_t)(32 * (T - 1)) * NPROJ);
                            f32x16 re0, re1, im0, im1;
                            s5_bu_tile(uc, bm1, r, h, re0, re1, im0, im1);
                            s5_scan_tile<true, false>(re0, re1, im0, im1, ar1, ai1, br_, bi_, nullptr, p); }
                    }
                }
                asm volatile("s_waitcnt lgkmcnt(0)" ::: "memory");
                for (int T = 0; T < S5L / 32; ++T) {
                    f32x4a y0 = {0.f, 0.f, 0.f, 0.f}, y1 = {0.f, 0.f, 0.f, 0.f};
                    const v4u uc = *(const v4u*)(ul + (size_t)(32 * T) * NPROJ);
                    {
                        *(v4u*)(xs + r * XSTR + 128 + 8 * h) = uc;
                        asm volatile("s_waitcnt lgkmcnt(0)" ::: "memory");
                        const bf16x8 u0 = *(const bf16x8*)(xs + cc * XSTR + 128 + 8 * fq), u1 = *(const bf16x8*)(xs + (16 + cc) * XSTR + 128 + 8 * fq);
                        y0 = MFMA16(u0, dg, y0); y1 = MFMA16(u1, dg, y1);
                    }
                    {
                        f32x16 re0, re1, im0, im1;
                        s5_bu_tile(uc, bm0, r, h, re0, re1, im0, im1);
                        s5_scan_tile<false, true>(re0, re1, im0, im1, ar0, ai0, fr_, fi_, xs, p);
                        asm volatile("s_waitcnt lgkmcnt(0)" ::: "memory");
#pragma unroll
                        for (int ks = 0; ks < 4; ++ks) {
                            const bf16x8 a0 = *(const bf16x8*)(xs + cc * XSTR + 32 * ks + 8 * fq), a1 = *(const bf16x8*)(xs + (16 + cc) * XSTR + 32 * ks + 8 * fq);
                            y0 = MFMA16(a0, cm0[ks], y0); y1 = MFMA16(a1, cm0[ks], y1);
                        }
                        asm volatile("s_waitcnt lgkmcnt(0)" ::: "memory");
                    }
                    {
                        float xr = sbuf[(T * 64 + p) * 2], xi = sbuf[(T * 64 + p) * 2 + 1];
                        f32x16 re0, re1, im0, im1;
                        s5_bu_tile(uc, bm1, r, h, re0, re1, im0, im1);
                        s5_scan_tile<true, true>(re0, re1, im0, im1, ar1, ai1, xr, xi, xs, p);
                        asm volatile("s_waitcnt lgkmcnt(0)" ::: "memory");
#pragma unroll
                        for (int ks = 0; ks < 4; ++ks) {
                            const bf16x8 a0 = *(const bf16x8*)(xs + cc * XSTR + 32 * ks + 8 * fq), a1 = *(const bf16x8*)(xs + (16 + cc) * XSTR + 32 * ks + 8 * fq);
                            y0 = MFMA16(a0, cm1[ks], y0); y1 = MFMA16(a1, cm1[ks], y1);
                        }
                        asm volatile("s_waitcnt lgkmcnt(0)" ::: "memory");
                    }
                    bf16* gp = GB + (size_t)(b * SEQ + c * S5L + 32 * T) * 256 + 16 * g + cc;
#pragma unroll
                    for (int j = 0; j < 4; ++j) { gp[(size_t)(4 * fq + j) * 256] = (bf16)f2bf(gelu_tanh(y0[j])); gp[(size_t)(16 + 4 * fq + j) * 256] = (bf16)f2bf(gelu_tanh(y1[j])); }
                }
            }
            {
                const bf16* CP0 = (const bf16*)(ws + WS_CP0); const bf16* CP1 = (const bf16*)(ws + WS_CP1); const bf16* CP2 = (const bf16*)(ws + WS_CP2); const float* CL = (const float*)(ws + WS_CL);
                for (int i = bx * NTHREADS + wave * 64 + lane; i < M * 32; i += 2 * G * NTHREADS) {
                    v4u a[2], bq[2], cq[2]; float inv[2]; bool ok[2];
#pragma unroll
                    for (int e = 0; e < 2; ++e) {
                        const int ie = i + e * G * NTHREADS; ok[e] = ie < M * 32; const int ic = ok[e] ? ie : i;
                        const int row = ic >> 5, pc = ic & 31, hd = pc >> 3;
                        const float l = CL[(size_t)row * 4 + hd] + CL[((size_t)M + row) * 4 + hd] + CL[((size_t)2 * M + row) * 4 + hd];
                        inv[e] = 1.0f / l;
                        a[e] = *(const v4u*)(CP0 + (size_t)row * 256 + 8 * pc); bq[e] = *(const v4u*)(CP1 + (size_t)row * 256 + 8 * pc); cq[e] = *(const v4u*)(CP2 + (size_t)row * 256 + 8 * pc);
                    }
#pragma unroll
                    for (int e = 0; e < 2; ++e) {
                        const int ie = i + e * G * NTHREADS; const int row = ie >> 5, pc = ie & 31;
                        v4u w;
                        w.x = pk2((bf_lo(a[e].x) + bf_lo(bq[e].x) + bf_lo(cq[e].x)) * inv[e], (bf_hi(a[e].x) + bf_hi(bq[e].x) + bf_hi(cq[e].x)) * inv[e]);
                        w.y = pk2((bf_lo(a[e].y) + bf_lo(bq[e].y) + bf_lo(cq[e].y)) * inv[e], (bf_hi(a[e].y) + bf_hi(bq[e].y) + bf_hi(cq[e].y)) * inv[e]);
                        w.z = pk2((bf_lo(a[e].z) + bf_lo(bq[e].z) + bf_lo(cq[e].z)) * inv[e], (bf_hi(a[e].z) + bf_hi(bq[e].z) + bf_hi(cq[e].z)) * inv[e]);
                        w.w = pk2((bf_lo(a[e].w) + bf_lo(bq[e].w) + bf_lo(cq[e].w)) * inv[e], (bf_hi(a[e].w) + bf_hi(bq[e].w) + bf_hi(cq[e].w)) * inv[e]);
                        if (ok[e]) *(v4u*)(MIX + (size_t)row * D + 512 + 8 * pc) = w;
                    }
                }
            }
        }
#endif
        xcd_barrier(xbar);
        { int kglu = 256; asm volatile("" : "+s"(kglu));
          pg8::Gemm g{GB, (const bf16*)(wl + WO_GLU), M, 256, kglu}; pg8::StaticOrder S; S.init(M, 256, G, bx);
          pg8::EpiGLU E{GB, MIX};
          pg8::gemm_phase<pg8::EpiGLU, pg8::StaticOrder, true, true>(ldsl, g, S, E, wave); }
        xcd_barrier(xbar);
        { pg8::Gemm g{MIX, (const bf16*)(wl + WO_OUT), M, D, D}; pg8::StaticOrder S; S.init(M, D, G, bx);
          pg8::EpiRes E{nullptr, XB, ssq2, 1.0f};
          pg8::gemm_phase<pg8::EpiRes, pg8::StaticOrder, true, true>(ldsl, g, S, E, wave); }
        xcd_barrier(xbar);
        { pg8::Gemm g{XB, (const bf16*)(wl + WO_4), M, 2 * FF, D}; pg8::StaticOrder S; S.init(M, 2 * FF, G, bx);
          pg8::EpiSwiGLU E{HB, ssq2};
          pg8::gemm_phase<pg8::EpiSwiGLU, pg8::StaticOrder, true, true, (RESID_F16 != 0)>(ldsl, g, S, E, wave); }
        xcd_barrier(xbar);
        { pg8::Gemm g{HB, (const bf16*)(wl + WO_5), M, D, FF}; pg8::StaticOrder S; S.init(M, D, G, bx);
          pg8::EpiRes E{layer == DEPTH - 1 ? out : nullptr, XB, ssq3, 0.5f};
          pg8::gemm_phase<pg8::EpiRes, pg8::StaticOrder, true, true>(ldsl, g, S, E, wave); }
        if (layer < DEPTH - 1) xcd_barrier(xbar);
    }
}

extern "C" void kernel_launch(void* const* d_in, const int* in_sizes, int n_in, void* d_out, int out_size, void* d_ws, size_t ws_size, hipStream_t stream) {
    static int grid = 0;
    if (grid == 0) {
        if (n_in != 22 || in_sizes[0] != M * D || out_size != M * D || ws_size < WS_END) { fprintf(stderr, "kernel_launch: unexpected shapes (n_in %d, in0 %d, out %d, ws %zu)\n", n_in, n_in > 0 ? in_sizes[0] : -1, out_size, ws_size); grid = -1; return; }
        int dev = 0, cus = 0, per_cu = 0;
        hipGetDevice(&dev);
        hipDeviceGetAttribute(&cus, hipDeviceAttributeMultiprocessorCount, dev);
        if (hipFuncSetAttribute((const void*)hybrid_fwd, hipFuncAttributeMaxDynamicSharedMemorySize, LDS_BYTES) != hipSuccess) { fprintf(stderr, "kernel_launch: hipFuncSetAttribute failed\n"); grid = -1; return; }
        if (hipOccupancyMaxActiveBlocksPerMultiprocessor(&per_cu, (const void*)hybrid_fwd, NTHREADS, LDS_BYTES) != hipSuccess || per_cu < 1) { fprintf(stderr, "kernel_launch: occupancy query says %d blocks per CU\n", per_cu); per_cu = 1; }
        (void)hipGetLastError();
        grid = cus * 1;
    }
    if (grid < 0) return;
    Args a{};
    for (int i = 0; i < 22; ++i) a.in[i] = (const float*)d_in[i];
    a.out = (float*)d_out; a.ws = (unsigned char*)d_ws;
    void* kargs[] = {&a};
    hipError_t e = hipLaunchCooperativeKernel((const void*)hybrid_fwd, dim3(grid), dim3(NTHREADS), kargs, LDS_BYTES, stream);
    if (e != hipSuccess) fprintf(stderr, "kernel_launch: cooperative launch failed: %s (grid %d)\n", hipGetErrorString(e), grid);
}
```

```cpp
#include <hip/hip_runtime.h>
#include <hip/hip_cooperative_groups.h>
#include <cstdio>
#include <cstdint>
namespace cg = cooperative_groups;
__device__ __forceinline__ int fresh_lane_id() { unsigned z = 0u; asm volatile("" : "+v"(z)); return (int)__builtin_amdgcn_mbcnt_hi(~0u, __builtin_amdgcn_mbcnt_lo(~0u, z)); }
namespace pg8 {
#define PG8_LAS __attribute__((address_space(3)))
typedef unsigned short bf16_t;
typedef short bf16x8 __attribute__((ext_vector_type(8)));
typedef float f32x4 __attribute__((ext_vector_type(4)));
typedef unsigned u32x4 __attribute__((ext_vector_type(4)));
constexpr int BM = 256, BK = 64, HALF = 128, HTB = HALF * BK * 2  , STAGE_BYTES = 8 * HTB, NXCD = 8, WGM = 8;

__host__ __device__ __forceinline__ int lds_byte(int r, int c) { const int st = (r >> 4) * 2 + (c >> 5), rr = r & 15, cc = c & 31, ob = rr * 64 + cc * 2; return st * 1024 + (ob ^ (((ob >> 9) & 1) << 5)); }
__host__ __device__ __forceinline__ void stage_rc(int b, int& R, int& C) { const int st = b / 1024, sb = b % 1024, swz = sb ^ (((sb >> 9) & 1) << 5); R = (st >> 1) * 16 + swz / 64; C = (st & 1) * 32 + (swz % 64) / 2; }
__host__ __device__ __forceinline__ int perm32(int rho) { const int n = rho >> 4, i = rho & 15; return 8 * (i >> 2) + 4 * n + (i & 3); }

struct Unit { int pm, pn; };
struct Gemm { const bf16_t* A; const bf16_t* Bt; int M, N, K; };

struct StaticOrder {
    int nM, nN, nwg, G, c;
    __host__ __device__ void init(int M, int N, int G_, int c_) { nM = M / BM; nN = N / BM; nwg = nM * nN; G = G_; c = c_; }
    __host__ __device__ bool next(int i, Unit& u) const {
        const long L = (long)i * G + c; if (L >= nwg) return false;
        int wgid = (int)L; { const int q = nwg / NXCD, r = nwg % NXCD, xcd = wgid % NXCD, off = wgid / NXCD; wgid = (xcd < r ? xcd * (q + 1) : r * (q + 1) + (xcd - r) * q) + off; }
        const int nig = WGM * nN, gid = wgid / nig, fm = gid * WGM, gsz = (nM - fm) < WGM ? (nM - fm) : WGM;
        u.pm = fm + ((wgid % nig) % gsz); u.pn = (wgid % nig) / gsz; return true;
    }
    __device__ __forceinline__ void a_ready(const Unit&) const {}
    __device__ __forceinline__ void done(const Unit&) const {}
};

__device__ __forceinline__ unsigned cvt_pk_bf16(float lo, float hi) { unsigned r; asm volatile("v_cvt_pk_bf16_f32 %0, %1, %2" : "=v"(r) : "v"(lo), "v"(hi)); return r; }
#ifndef RESID_F16
#define RESID_F16 1
#endif
__device__ __forceinline__ float bf_lo(unsigned w) { return __builtin_bit_cast(float, w << 16); }
__device__ __forceinline__ float bf_hi(unsigned w) { return __builtin_bit_cast(float, w & 0xffff0000u); }
typedef _Float16 f16x8 __attribute__((ext_vector_type(8)));
typedef _Float16 f16x2 __attribute__((ext_vector_type(2)));
typedef float f32x2e __attribute__((ext_vector_type(2)));
template <bool F16> __device__ __forceinline__ f32x4 mma16(bf16x8 a, bf16x8 b, f32x4 c) {
    if constexpr (F16) return __builtin_amdgcn_mfma_f32_16x16x32_f16(__builtin_bit_cast(f16x8, a), __builtin_bit_cast(f16x8, b), c, 0, 0, 0);
    else return __builtin_amdgcn_mfma_f32_16x16x32_bf16(a, b, c, 0, 0, 0);
}
__device__ __forceinline__ unsigned pk_f16(float lo, float hi) { f32x2e v = {lo, hi}; return __builtin_bit_cast(unsigned, __builtin_convertvector(v, f16x2)); }
#ifndef XB_BITS
#define XB_BITS 8
#endif
__device__ __forceinline__ float rnd_sig(float v) { unsigned u = __builtin_bit_cast(unsigned, v); constexpr unsigned D = 23 - XB_BITS; u = (u + ((1u << (D - 1)) - 1u) + ((u >> D) & 1u)) & ~((1u << D) - 1u); return __builtin_bit_cast(float, u); }
__device__ __forceinline__ unsigned pk_f16r(float lo, float hi) { f32x2e v = {rnd_sig(lo), rnd_sig(hi)}; return __builtin_bit_cast(unsigned, __builtin_convertvector(v, f16x2)); }
__device__ __forceinline__ float h_lo(unsigned w) { return (float)__builtin_bit_cast(f16x2, w)[0]; }
__device__ __forceinline__ float h_hi(unsigned w) { return (float)__builtin_bit_cast(f16x2, w)[1]; }
__device__ __forceinline__ float sigmoid_f(float v) { return __builtin_amdgcn_rcpf(1.0f + __expf(-v)); }
__device__ __forceinline__ float row_rstd(const float* ssq, int row) {
    const f32x4* p = (const f32x4*)(ssq + (size_t)row * 16); const f32x4 a = p[0], b = p[1], c = p[2], d = p[3];
    const float s = ((a[0] + a[1]) + (a[2] + a[3])) + ((b[0] + b[1]) + (b[2] + b[3])) + (((c[0] + c[1]) + (c[2] + c[3])) + ((d[0] + d[1]) + (d[2] + d[3])));
    return __builtin_amdgcn_rsqf(s * (1.0f / 1024.0f) + 1e-6f);
}

constexpr int RS_LDS_OFF = 131072 + 2048;
__device__ __forceinline__ void rows_rstd_pre(const float* ssq, const Unit& u, int tid, f32x4 (&pre)[2]) {
    const f32x4* p = (const f32x4*)(ssq + (size_t)(u.pm * BM + (tid >> 1)) * 16 + 8 * (tid & 1));
    pre[0] = p[0]; pre[1] = p[1];
}
__device__ __forceinline__ void rows_rstd_lds(const f32x4 (&pre)[2], int wr, int wc, int fr, int fq, float (&rs)[2][4]) {
    PG8_LAS float* rl = (PG8_LAS float*)((PG8_LAS unsigned char*)0 + RS_LDS_OFF);
    const int t = (wr * 4 + wc) * 64 + fq * 16 + fr, rowl = t >> 1, hf = t & 1;
    const f32x4 a = pre[0], b = pre[1];
    float sm = ((a[0] + a[1]) + (a[2] + a[3])) + ((b[0] + b[1]) + (b[2] + b[3]));
    sm += __shfl_xor(sm, 1);
    if (hf == 0) rl[rowl] = __builtin_amdgcn_rsqf(sm * (1.0f / 1024.0f) + 1e-6f);
    asm volatile("s_waitcnt lgkmcnt(0)" ::: "memory");
    __builtin_amdgcn_s_barrier();
#pragma unroll
    for (int ai = 0; ai < 2; ++ai)
#pragma unroll
        for (int m = 0; m < 4; ++m) rs[ai][m] = rl[ai * HALF + wr * 64 + m * 16 + fr];
}

struct EpiSwiGLU {
    static constexpr bool PERM = true, AFTER_DRAIN = false, HAS_PRE = true;
    bf16_t* H; const float* ssq;
    __device__ __forceinline__ void prefetch(const Unit& u, int tid, f32x4 (&pre)[2]) const { rows_rstd_pre(ssq, u, tid, pre); }
    __device__ __forceinline__ void operator()(const f32x4 (&acc)[2][2][4][2], const Unit& u, int wr, int wc, int fr, int fq, const f32x4 (&pre)[2]) const {
        const int row0 = u.pm * BM + wr * 64 + fr; const int hc = u.pn * 128 + wc * 32 + 8 * fq;
        float rsv[2][4]; rows_rstd_lds(pre, wr, wc, fr, fq, rsv);
#pragma unroll
        for (int ai = 0; ai < 2; ++ai)
#pragma unroll
            for (int m = 0; m < 4; ++m) {
                const int row = row0 + ai * HALF + m * 16;
                const float rs = rsv[ai][m];
                float h[8];
#pragma unroll
                for (int n = 0; n < 2; ++n)
#pragma unroll
                    for (int j = 0; j < 4; ++j) { const float g = acc[ai][0][m][n][j] * rs, up = acc[ai][1][m][n][j] * rs; h[4 * n + j] = g * sigmoid_f(g) * up; }
                u32x4 w; w.x = cvt_pk_bf16(h[0], h[1]); w.y = cvt_pk_bf16(h[2], h[3]); w.z = cvt_pk_bf16(h[4], h[5]); w.w = cvt_pk_bf16(h[6], h[7]);
                *(u32x4*)(H + (size_t)row * 2816 + hc) = w;
            }
    }
};

struct EpiRes {
    static constexpr bool PERM = true, AFTER_DRAIN = false, HAS_PRE = false;
    float* xout32; bf16_t* XB; float* ssq_next; float sc;
    __device__ __forceinline__ void operator()(const f32x4 (&acc)[2][2][4][2], const Unit& u, int wr, int wc, int fr, int fq) const {
        const int row0 = u.pm * BM + wr * 64 + fr; const int c0 = u.pn * BM + wc * 32 + 8 * fq;
#pragma unroll
        for (int ai = 0; ai < 2; ++ai) {
            u32x4 xa[4][2];
#pragma unroll
            for (int m = 0; m < 4; ++m)
#pragma unroll
                for (int bj = 0; bj < 2; ++bj) xa[m][bj] = *(const u32x4*)(XB + (size_t)(row0 + ai * HALF + m * 16) * 1024 + c0 + bj * HALF);
#pragma unroll
            for (int m = 0; m < 4; ++m) {
                const int row = row0 + ai * HALF + m * 16; float ss = 0.f;
#pragma unroll
                for (int bj = 0; bj < 2; ++bj) {
                    const size_t o = (size_t)row * 1024 + c0 + bj * HALF;
                    const u32x4 xw = xa[m][bj];
#if RESID_F16
                    f32x4 a = {h_lo(xw.x), h_hi(xw.x), h_lo(xw.y), h_hi(xw.y)}, b = {h_lo(xw.z), h_hi(xw.z), h_lo(xw.w), h_hi(xw.w)};
#else
                    f32x4 a = {bf_lo(xw.x), bf_hi(xw.x), bf_lo(xw.y), bf_hi(xw.y)}, b = {bf_lo(xw.z), bf_hi(xw.z), bf_lo(xw.w), bf_hi(xw.w)};
#endif
                    a = a + acc[ai][bj][m][0] * sc; b = b + acc[ai][bj][m][1] * sc;
                    if (xout32) { *(f32x4*)(xout32 + o) = a; *(f32x4*)(xout32 + o + 4) = b; }
#if RESID_F16
                    u32x4 w; w.x = pk_f16r(a[0], a[1]); w.y = pk_f16r(a[2], a[3]); w.z = pk_f16r(b[0], b[1]); w.w = pk_f16r(b[2], b[3]);
#else
                    u32x4 w; w.x = cvt_pk_bf16(a[0], a[1]); w.y = cvt_pk_bf16(a[2], a[3]); w.z = cvt_pk_bf16(b[0], b[1]); w.w = cvt_pk_bf16(b[2], b[3]);
#endif
                    if (!xout32) *(u32x4*)(XB + o) = w;
                    ss += (a[0] * a[0] + a[1] * a[1]) + (a[2] * a[2] + a[3] * a[3]) + (b[0] * b[0] + b[1] * b[1]) + (b[2] * b[2] + b[3] * b[3]);
                }
                ss += __shfl_xor(ss, 16); ss += __shfl_xor(ss, 32);
                if (fq == 0 && !xout32) ssq_next[(size_t)row * 16 + u.pn * 4 + wc] = ss;
            }
            asm volatile("" ::: "memory");
        }
    }
};

struct EpiInProj {
    static constexpr bool PERM = true, AFTER_DRAIN = false, HAS_PRE = true;
    bf16_t* P; const float* ssq; const float* qkg;
    __device__ __forceinline__ void prefetch(const Unit& u, int tid, f32x4 (&pre)[2]) const { rows_rstd_pre(ssq, u, tid, pre); }
    __device__ __forceinline__ void operator()(const f32x4 (&acc)[2][2][4][2], const Unit& u, int wr, int wc, int fr, int fq, const f32x4 (&pre)[2]) const {
        const int row0 = u.pm * BM + wr * 64 + fr; const int hh = 4 * u.pn + wc;
        int gidx = -1;
        if (hh < 4) gidx = 0; else if (hh < 6) gidx = 1; else if (hh < 12) gidx = -1; else if (hh < 16) gidx = 2; else if (hh < 20) gidx = 3; else if (hh < 24) gidx = -1; else if (hh < 28) gidx = 4; else if (hh < 32) gidx = 5;
        const int cb = u.pn * BM + wc * 64 + 8 * fq;
        float rsv[2][4]; rows_rstd_lds(pre, wr, wc, fr, fq, rsv);
        f32x4 gv[2][2];
#pragma unroll
        for (int bj = 0; bj < 2; ++bj)
#pragma unroll
            for (int n = 0; n < 2; ++n) gv[bj][n] = (gidx >= 0) ? *(const f32x4*)(qkg + gidx * 64 + 32 * bj + 8 * fq + 4 * n) : (f32x4){1.f, 1.f, 1.f, 1.f};
#pragma unroll
        for (int ai = 0; ai < 2; ++ai)
#pragma unroll
            for (int m = 0; m < 4; ++m) {
                const int row = row0 + ai * HALF + m * 16;
                const float rs = rsv[ai][m];
                f32x4 v[2][2]; float ss = 0.f;
#pragma unroll
                for (int bj = 0; bj < 2; ++bj)
#pragma unroll
                    for (int n = 0; n < 2; ++n) { v[bj][n] = acc[ai][bj][m][n] * rs; const f32x4 t = v[bj][n]; ss += (t[0] * t[0] + t[1] * t[1]) + (t[2] * t[2] + t[3] * t[3]); }
                if (gidx >= 0) {
                    ss += __shfl_xor(ss, 16); ss += __shfl_xor(ss, 32);
                    const float r2 = __builtin_amdgcn_rsqf(ss * (1.0f / 64.0f) + 1e-6f);
#pragma unroll
                    for (int bj = 0; bj < 2; ++bj)
#pragma unroll
                        for (int n = 0; n < 2; ++n) v[bj][n] = v[bj][n] * r2 * gv[bj][n];
                }
#pragma unroll
                for (int bj = 0; bj < 2; ++bj) {
                    u32x4 w; w.x = cvt_pk_bf16(v[bj][0][0], v[bj][0][1]); w.y = cvt_pk_bf16(v[bj][0][2], v[bj][0][3]); w.z = cvt_pk_bf16(v[bj][1][0], v[bj][1][1]); w.w = cvt_pk_bf16(v[bj][1][2], v[bj][1][3]);
                    *(u32x4*)(P + (size_t)row * 2304 + cb + 32 * bj) = w;
                }
            }
    }
};

struct EpiGLU {
    static constexpr bool PERM = true, AFTER_DRAIN = false, HAS_PRE = false;
    const bf16_t* G; bf16_t* MIX;
    __device__ __forceinline__ void operator()(const f32x4 (&acc)[2][2][4][2], const Unit& u, int wr, int wc, int fr, int fq) const {
        const int row0 = u.pm * BM + wr * 64 + fr; const int c0 = wc * 32 + 8 * fq;
#pragma unroll
        for (int ai = 0; ai < 2; ++ai) {
            u32x4 gq[4][2];
#pragma unroll
            for (int m = 0; m < 4; ++m)
#pragma unroll
                for (int bj = 0; bj < 2; ++bj) gq[m][bj] = *(const u32x4*)(G + (size_t)(row0 + ai * HALF + m * 16) * 256 + c0 + bj * HALF);
#pragma unroll
            for (int m = 0; m < 4; ++m) {
                const int row = row0 + ai * HALF + m * 16;
#pragma unroll
                for (int bj = 0; bj < 2; ++bj) {
                    const int c = c0 + bj * HALF;
                    const u32x4 gw = gq[m][bj];
                    const f32x4 a0 = acc[ai][bj][m][0], a1 = acc[ai][bj][m][1];
                    u32x4 w;
                    w.x = cvt_pk_bf16(bf_lo(gw.x) * sigmoid_f(a0[0]), bf_hi(gw.x) * sigmoid_f(a0[1]));
                    w.y = cvt_pk_bf16(bf_lo(gw.y) * sigmoid_f(a0[2]), bf_hi(gw.y) * sigmoid_f(a0[3]));
                    w.z = cvt_pk_bf16(bf_lo(gw.z) * sigmoid_f(a1[0]), bf_hi(gw.z) * sigmoid_f(a1[1]));
                    w.w = cvt_pk_bf16(bf_lo(gw.w) * sigmoid_f(a1[2]), bf_hi(gw.w) * sigmoid_f(a1[3]));
                    *(u32x4*)(MIX + (size_t)row * 1024 + 256 + c) = w;
                }
            }
            asm volatile("" ::: "memory");
        }
    }
};

template <class Epi, class Sched, bool ALIGN_EPI = false, bool SP2 = false, bool F16 = false>
__device__ __forceinline__ void gemm_phase(PG8_LAS unsigned char* lds, const Gemm g, const Sched& S, const Epi& E, const int wave_id) {
    int tid_ = wave_id * 64 + fresh_lane_id(); asm volatile("" : "+v"(tid_));
    const int tid = tid_, wid = __builtin_amdgcn_readfirstlane(tid >> 6), lane = tid & 63, wr = wid >> 2, wc = wid & 3, fr = lane & 15, fq = lane >> 4;
    const int K = g.K, nt = K / BK;
    unsigned voffA[2], voffB[2];
#pragma unroll
    for (int i = 0; i < 2; ++i) { int R, C; stage_rc(tid * 16 + i * 8192, R, C); const int Rb = Epi::PERM ? ((R & ~31) + perm32(R & 31)) : R;
        voffA[i] = (unsigned)(R * K + C) * 2u; voffB[i] = (unsigned)(Rb * K + C) * 2u; }
    const size_t kstep = (size_t)(BK * 2);
    const size_t hstep = (size_t)HALF * K * 2;
    const size_t tstep = 2 * hstep;
    const unsigned ldsw = (unsigned)wid * 1024u;
    const int aoff = lds_byte(wr * 64 + fr, fq * 8), boff = lds_byte(wc * 32 + fr, fq * 8);
#define PG8_SA(b, h) (((b) * 2 + (h)) * HTB)
#define PG8_SB(b, h) ((4 + (b) * 2 + (h)) * HTB)
#define PG8_STAGE(bufoff, gbase, voff) do { _Pragma("unroll") for (int _i = 0; _i < 2; ++_i) \
        __builtin_amdgcn_global_load_lds((const unsigned*)((const char*)(gbase) + (voff)[_i]), (PG8_LAS unsigned*)(lds + (bufoff) + ldsw + _i * 8192), 16, 0, 0); } while (0)
#define PG8_LDA(dst, b, h) do { _Pragma("unroll") for (int m = 0; m < 4; ++m) _Pragma("unroll") for (int k = 0; k < 2; ++k) dst[m][k] = *(const PG8_LAS bf16x8*)(lds + PG8_SA(b, h) + aoff + m * 2048 + k * 1024); } while (0)
#define PG8_LDB(dst, b, h) do { _Pragma("unroll") for (int n = 0; n < 2; ++n) _Pragma("unroll") for (int k = 0; k < 2; ++k) dst[n][k] = *(const PG8_LAS bf16x8*)(lds + PG8_SB(b, h) + boff + n * 2048 + k * 1024); } while (0)
#define PG8_MMA(ai, bj, At, Bt) do { __builtin_amdgcn_s_setprio(1); _Pragma("unroll") for (int m = 0; m < 4; ++m) _Pragma("unroll") for (int n = 0; n < 2; ++n) _Pragma("unroll") for (int k = 0; k < 2; ++k) \
        acc[ai][bj][m][n] = mma16<F16>(Bt[n][k], At[m][k], acc[ai][bj][m][n]); __builtin_amdgcn_s_setprio(0); } while (0)
#define PG8_WAIT_V(n) asm volatile("s_waitcnt vmcnt(" #n ")" ::: "memory")
#define PG8_WAIT_L(n) asm volatile("s_waitcnt lgkmcnt(" #n ")" ::: "memory")
#define PG8_BAR __builtin_amdgcn_s_barrier()
#define PG8_SCHED __builtin_amdgcn_sched_barrier(0)
    Unit cur, nxt; int ui = 0;
    if (!S.next(0, cur)) return;
    f32x4 acc[2][2][4][2];
#pragma unroll
    for (int a = 0; a < 2; ++a)
#pragma unroll
        for (int b = 0; b < 2; ++b)
#pragma unroll
            for (int m = 0; m < 4; ++m)
#pragma unroll
                for (int n = 0; n < 2; ++n) acc[a][b][m][n] = (f32x4){0.f, 0.f, 0.f, 0.f};
    bf16x8 At[4][2], B0[2][2], B1[2][2];
    f32x4 epre[2];
    const char* cA = (const char*)g.A + (size_t)cur.pm * tstep; const char* cB = (const char*)g.Bt + (size_t)cur.pn * tstep;
    S.a_ready(cur);
    if constexpr (SP2) {
        PG8_STAGE(PG8_SB(0, 0), cB, voffB); PG8_STAGE(PG8_SB(0, 1), cB + hstep, voffB); PG8_STAGE(PG8_SA(0, 0), cA, voffA); PG8_STAGE(PG8_SA(0, 1), cA + hstep, voffA);
        if (wr == 1) PG8_BAR;
        PG8_WAIT_V(2); PG8_BAR;
        PG8_STAGE(PG8_SB(1, 0), cB + kstep, voffB); PG8_STAGE(PG8_SA(1, 0), cA + kstep, voffA); PG8_STAGE(PG8_SB(1, 1), cB + hstep + kstep, voffB);
        PG8_WAIT_V(6); PG8_BAR;
    } else {
        PG8_STAGE(PG8_SB(0, 0), cB, voffB); PG8_STAGE(PG8_SA(0, 0), cA, voffA); PG8_STAGE(PG8_SB(0, 1), cB + hstep, voffB); PG8_STAGE(PG8_SA(0, 1), cA + hstep, voffA);
        if (wr == 1) PG8_BAR;
        PG8_WAIT_V(4); PG8_BAR;
        PG8_STAGE(PG8_SB(1, 0), cB + kstep, voffB); PG8_STAGE(PG8_SA(1, 0), cA + kstep, voffA); PG8_STAGE(PG8_SB(1, 1), cB + hstep + kstep, voffB);
        PG8_WAIT_V(6); PG8_BAR;
    }
    for (;;) {
        const bool has_next = S.next(ui + 1, nxt);
        const char* nA = has_next ? (const char*)g.A + (size_t)nxt.pm * tstep : cA; const char* nB = has_next ? (const char*)g.Bt + (size_t)nxt.pn * tstep : cB;
        for (int t = 0; t < nt; t += 2) {
            const bool last = (t == nt - 2);
            if constexpr (Epi::HAS_PRE) { if (last) E.prefetch(cur, tid, epre); }
            const char* a1 = cA + (size_t)(t + 1) * kstep;
            const char* a2 = last ? nA : cA + (size_t)(t + 2) * kstep; const char* b2 = last ? nB : cB + (size_t)(t + 2) * kstep;
            const char* a3 = a2 + kstep; const char* b3 = b2 + kstep;
            if (last && has_next) S.a_ready(nxt);
            if constexpr (SP2) {
            PG8_LDB(B0, 0, 0); PG8_LDB(B1, 0, 1); PG8_SCHED; PG8_LDA(At, 0, 0); PG8_STAGE(PG8_SA(1, 1), a1 + hstep, voffA);
            PG8_WAIT_V(8); PG8_WAIT_L(0); PG8_BAR; PG8_MMA(0, 0, At, B0); PG8_MMA(0, 1, At, B1); PG8_BAR; PG8_SCHED;
            PG8_LDA(At, 0, 1); PG8_STAGE(PG8_SB(0, 0), b2, voffB); PG8_STAGE(PG8_SB(0, 1), b2 + hstep, voffB); PG8_STAGE(PG8_SA(0, 0), a2, voffA);
            PG8_WAIT_V(8); PG8_WAIT_L(0); PG8_BAR; PG8_MMA(1, 0, At, B0); PG8_MMA(1, 1, At, B1); PG8_BAR; PG8_SCHED;
            PG8_LDB(B0, 1, 0); PG8_LDB(B1, 1, 1); PG8_SCHED; PG8_LDA(At, 1, 0); PG8_STAGE(PG8_SA(0, 1), a2 + hstep, voffA);
            PG8_WAIT_V(8); PG8_WAIT_L(0); PG8_BAR; PG8_MMA(0, 0, At, B0); PG8_MMA(0, 1, At, B1); PG8_BAR; PG8_SCHED;
            PG8_LDA(At, 1, 1); PG8_STAGE(PG8_SB(1, 0), b3, voffB); PG8_STAGE(PG8_SB(1, 1), b3 + hstep, voffB); PG8_STAGE(PG8_SA(1, 0), a3, voffA);
            PG8_WAIT_V(8); PG8_WAIT_L(0); PG8_BAR; PG8_MMA(1, 0, At, B0); PG8_MMA(1, 1, At, B1); PG8_BAR; PG8_SCHED;
            } else {
            PG8_LDB(B0, 0, 0); PG8_SCHED; PG8_LDA(At, 0, 0); PG8_STAGE(PG8_SA(1, 1), a1 + hstep, voffA);
            PG8_WAIT_L(8); PG8_BAR; PG8_WAIT_L(0); PG8_MMA(0, 0, At, B0); PG8_BAR; PG8_SCHED;
            PG8_LDB(B1, 0, 1); PG8_STAGE(PG8_SB(0, 0), b2, voffB);
            PG8_BAR; PG8_WAIT_L(0); PG8_MMA(0, 1, At, B1); PG8_BAR;
            PG8_LDA(At, 0, 1); PG8_STAGE(PG8_SA(0, 0), a2, voffA);
            PG8_BAR; PG8_WAIT_L(0); PG8_MMA(1, 0, At, B0); PG8_BAR; PG8_SCHED;
            PG8_STAGE(PG8_SB(0, 1), b2 + hstep, voffB);
            PG8_WAIT_V(6); PG8_BAR; PG8_MMA(1, 1, At, B1); PG8_BAR;
            PG8_LDB(B0, 1, 0); PG8_SCHED; PG8_LDA(At, 1, 0); PG8_STAGE(PG8_SA(0, 1), a2 + hstep, voffA);
            PG8_WAIT_L(8); PG8_BAR; PG8_WAIT_L(0); PG8_MMA(0, 0, At, B0); PG8_BAR; PG8_SCHED;
            PG8_LDB(B1, 1, 1); PG8_STAGE(PG8_SB(1, 0), b3, voffB);
            PG8_BAR; PG8_WAIT_L(0); PG8_MMA(0, 1, At, B1); PG8_BAR;
            PG8_LDA(At, 1, 1); PG8_STAGE(PG8_SA(1, 0), a3, voffA);
            PG8_BAR; PG8_WAIT_L(0); PG8_MMA(1, 0, At, B0); PG8_BAR; PG8_SCHED;
            PG8_STAGE(PG8_SB(1, 1), b3 + hstep, voffB);
            PG8_WAIT_V(6); PG8_BAR; PG8_MMA(1, 1, At, B1); PG8_BAR;
            }
        }
        if constexpr (ALIGN_EPI) { if (wr == 0) PG8_BAR; }
        if constexpr (!Epi::AFTER_DRAIN) { if constexpr (Epi::HAS_PRE) E(acc, cur, wr, wc, fr, fq, epre); else E(acc, cur, wr, wc, fr, fq); S.done(cur); }
        if (!has_next) break;
#pragma unroll
        for (int a = 0; a < 2; ++a)
#pragma unroll
            for (int b = 0; b < 2; ++b)
#pragma unroll
                for (int m = 0; m < 4; ++m)
#pragma unroll
                    for (int n = 0; n < 2; ++n) acc[a][b][m][n] = (f32x4){0.f, 0.f, 0.f, 0.f};
        cur = nxt; cA = nA; cB = nB; ++ui;
        if constexpr (ALIGN_EPI) { if (wr == 1) PG8_BAR; }
    }
    PG8_WAIT_V(0);
    if constexpr (!ALIGN_EPI) { if (wr == 0) PG8_BAR; }
    PG8_BAR;
    if constexpr (Epi::AFTER_DRAIN) { E.fused(acc, cur, wr, wc, fr, fq, lds, wid, lane); S.done(cur); }
#undef PG8_SA
#undef PG8_SB
#undef PG8_STAGE
#undef PG8_LDA
#undef PG8_LDB
#undef PG8_MMA
#undef PG8_WAIT_V
#undef PG8_WAIT_L
#undef PG8_BAR
#undef PG8_SCHED
}
}
#define LAS __attribute__((address_space(3)))
typedef unsigned short bf16;
typedef unsigned v4u __attribute__((ext_vector_type(4)));
typedef float f32x4 __attribute__((ext_vector_type(4)));
#define LDS_WAIT() asm volatile("s_waitcnt lgkmcnt(0)" ::: "memory")

constexpr int NWAVES = 8, NTHREADS = 512;
constexpr int BATCH = 2, SEQ = 16384, M = BATCH * SEQ, D = 1024, FF = 2816, NPROJ = 2304, DEPTH = 4;
constexpr int P_AQ = 0, P_AK = 256, P_AV = 384, P_BU = 512, P_CQ = 768, P_CK = 1024, P_CV = 1280, P_DQ = 1536, P_DK = 1792, P_DV = 2048;
constexpr int S5L = 256, NCH = SEQ / S5L;
constexpr size_t MiB = 1u << 20;
constexpr size_t WS_W = 4 * MiB, W_LAYER = 40 * MiB;
constexpr size_t WO_1 = 0, WO_2 = 11 * MiB, WO_3 = 33 * MiB / 2, WO_GLU = 21 * MiB, WO_OUT = 43 * MiB / 2, WO_4 = 47 * MiB / 2, WO_5 = 69 * MiB / 2;
constexpr size_t WS_XB = 164 * MiB, WS_MIX = 228 * MiB, WS_H = 292 * MiB, WS_P = WS_H, WS_G = WS_H + 144 * MiB;
constexpr size_t WS_SEND = 468 * MiB, WS_SSQ = 476 * MiB, WS_SPREP = 478 * MiB, WS_END = 512 * MiB;
constexpr size_t WS_CP0 = 452 * MiB, WS_CP1 = 480 * MiB, WS_CP2 = 496 * MiB, WS_CL = 470 * MiB;
constexpr int SPREP_STRIDE = 2560;
constexpr int LDS_BYTES = 147456;
#ifndef REP_MIX1
#define REP_MIX1 1
#endif
#ifndef REP_MIX2
#define REP_MIX2 1
#endif
#ifndef REP_G1
#define REP_G1 1
#endif

__device__ __forceinline__ unsigned f2bf(float f) { unsigned u = __builtin_bit_cast(unsigned, f); return (u + 0x7fffu + ((u >> 16) & 1u)) >> 16; }
__device__ __forceinline__ unsigned pk2(float lo, float hi) { return f2bf(lo) | (f2bf(hi) << 16); }
__device__ __forceinline__ float bf_lo(unsigned w) { return __builtin_bit_cast(float, w << 16); }
__device__ __forceinline__ float bf_hi(unsigned w) { return __builtin_bit_cast(float, w & 0xffff0000u); }
__device__ __forceinline__ float wave_sum(float v) {
#pragma unroll
    for (int o = 1; o < 64; o <<= 1) v += __shfl_xor(v, o);
    return v;
}

struct Args { const float* in[22]; float* out; unsigned char* ws; };

__device__ __forceinline__ void transpose_item(const float* W, int K, int N, bf16* WT, int nrow0, int col0, int k0, const float* gain, LAS float* scr, int lane, bool f16) {
    float wv[32];
#pragma unroll
    for (int i = 0; i < 32; ++i) { const int kk = 2 * i + (lane >> 5); wv[i] = W[(size_t)(k0 + kk) * N + col0 + (lane & 31)]; }
#pragma unroll
    for (int i = 0; i < 32; ++i) { const int kk = 2 * i + (lane >> 5); float w = wv[i]; if (gain) w *= gain[k0 + kk]; scr[kk * 33 + (lane & 31)] = w; }
    LDS_WAIT();
    const int c = lane & 7;
#pragma unroll
    for (int j = 0; j < 4; ++j) { const int n = (lane >> 3) + 8 * j; const LAS float* s = scr + (8 * c) * 33 + n;
        v4u o;
        if (f16) {
#define W8(v) __builtin_bit_cast(float, f2bf(v) << 16)
            o.x = pg8::pk_f16(W8(s[0 * 33]), W8(s[1 * 33])); o.y = pg8::pk_f16(W8(s[2 * 33]), W8(s[3 * 33])); o.z = pg8::pk_f16(W8(s[4 * 33]), W8(s[5 * 33])); o.w = pg8::pk_f16(W8(s[6 * 33]), W8(s[7 * 33]));
#undef W8
        }
        else { o.x = pk2(s[0 * 33], s[1 * 33]); o.y = pk2(s[2 * 33], s[3 * 33]); o.z = pk2(s[4 * 33], s[5 * 33]); o.w = pk2(s[6 * 33], s[7 * 33]); }
        *(v4u*)(WT + (size_t)(nrow0 + n) * K + k0 + 8 * c) = o; }
    LDS_WAIT();
}
__device__ __forceinline__ void transpose_mat(const float* W, int K, int N, bf16* WT, int mode, const float* gain, LAS float* scr, int item, int lane) {
    const int nblk = N / 32, kb = item / nblk, nb = item % nblk, n0 = 32 * nb;
    int col0 = n0;
    if (mode == 1) { const int pn = n0 >> 8, bj = (n0 >> 7) & 1, r0 = n0 & 127; col0 = bj * FF + 128 * pn + r0; }
    else if (mode == 2) { const int pn = n0 >> 8, bj = (n0 >> 7) & 1, wc = (n0 >> 5) & 3; col0 = 256 * pn + 64 * wc + 32 * bj; }
    transpose_item(W, K, N, WT, n0, col0, 64 * kb, gain, scr, lane, RESID_F16 && mode != 0);
}

__device__ __forceinline__ void sincos_d(double th, double& s, double& c) {
    const double k = __builtin_rint(th * 0.63661977236758134308);
    double r = __builtin_fma(-k, 1.57079632679489655800e+00, th);
    r = __builtin_fma(-k, 6.12323399573676603587e-17, r);
    const double r2 = r * r;
    double sp = -1.0 / 1307674368000.0; sp = sp * r2 + 1.0 / 6227020800.0; sp = sp * r2 - 1.0 / 39916800.0; sp = sp * r2 + 1.0 / 362880.0; sp = sp * r2 - 1.0 / 5040.0; sp = sp * r2 + 1.0 / 120.0; sp = sp * r2 - 1.0 / 6.0; sp = sp * r2 + 1.0;
    const double sr = sp * r;
    double cp = 1.0 / 20922789888000.0; cp = cp * r2 - 1.0 / 87178291200.0; cp = cp * r2 + 1.0 / 479001600.0; cp = cp * r2 - 1.0 / 3628800.0; cp = cp * r2 + 1.0 / 40320.0; cp = cp * r2 - 1.0 / 720.0; cp = cp * r2 + 1.0 / 24.0; cp = cp * r2 - 0.5; cp = cp * r2 + 1.0;
    const int q = ((int)k) & 3;
    s = (q == 0) ? sr : (q == 1) ? cp : (q == 2) ? -sr : -cp;
    c = (q == 0) ? cp : (q == 1) ? -sr : (q == 2) ? -cp : sr;
}

__device__ __forceinline__ void load_row64(const bf16* p, float (&q)[64]) {
    const v4u* p4 = (const v4u*)p;
#pragma unroll
    for (int c = 0; c < 8; ++c) { const v4u w = p4[c];
        q[8 * c + 0] = bf_lo(w.x); q[8 * c + 1] = bf_hi(w.x); q[8 * c + 2] = bf_lo(w.y); q[8 * c + 3] = bf_hi(w.y);
        q[8 * c + 4] = bf_lo(w.z); q[8 * c + 5] = bf_hi(w.z); q[8 * c + 6] = bf_lo(w.w); q[8 * c + 7] = bf_hi(w.w); }
}
__device__ __forceinline__ void attn_visit(const bf16* kp, const bf16* vp, float bias, const float (&q)[64], float (&o)[64], float& mx, float& l) {
    const v4u* k4 = (const v4u*)kp; const v4u* v4 = (const v4u*)vp;
    float s0 = 0.f, s1 = 0.f;
#pragma unroll
    for (int c = 0; c < 8; ++c) { const v4u w = k4[c];
        s0 += q[8 * c + 0] * bf_lo(w.x); s1 += q[8 * c + 1] * bf_hi(w.x); s0 += q[8 * c + 2] * bf_lo(w.y); s1 += q[8 * c + 3] * bf_hi(w.y);
        s0 += q[8 * c + 4] * bf_lo(w.z); s1 += q[8 * c + 5] * bf_hi(w.z); s0 += q[8 * c + 6] * bf_lo(w.w); s1 += q[8 * c + 7] * bf_hi(w.w); }
    const float s = (s0 + s1) * 0.125f + bias;
    const float mn = fmaxf(mx, s), corr = __expf(mx - mn), p = __expf(s - mn);
    l = l * corr + p; mx = mn;
#pragma unroll
    for (int c = 0; c < 8; ++c) { const v4u w = v4[c];
        o[8 * c + 0] = o[8 * c + 0] * corr + p * bf_lo(w.x); o[8 * c + 1] = o[8 * c + 1] * corr + p * bf_hi(w.x);
        o[8 * c + 2] = o[8 * c + 2] * corr + p * bf_lo(w.y); o[8 * c + 3] = o[8 * c + 3] * corr + p * bf_hi(w.y);
        o[8 * c + 4] = o[8 * c + 4] * corr + p * bf_lo(w.z); o[8 * c + 5] = o[8 * c + 5] * corr + p * bf_hi(w.z);
        o[8 * c + 6] = o[8 * c + 6] * corr + p * bf_lo(w.w); o[8 * c + 7] = o[8 * c + 7] * corr + p * bf_hi(w.w); }
}
__device__ __forceinline__ void store_row64(bf16* p, const float (&o)[64], float sc) {
    v4u* p4 = (v4u*)p;
#pragma unroll
    for (int c = 0; c < 8; ++c) { v4u w; w.x = pk2(o[8 * c + 0] * sc, o[8 * c + 1] * sc); w.y = pk2(o[8 * c + 2] * sc, o[8 * c + 3] * sc); w.z = pk2(o[8 * c + 4] * sc, o[8 * c + 5] * sc); w.w = pk2(o[8 * c + 6] * sc, o[8 * c + 7] * sc); p4[c] = w; }
}

__device__ __forceinline__ void load_u16(const bf16* p, float (&u)[16]) {
    const v4u* p4 = (const v4u*)p;
#pragma unroll
    for (int c = 0; c < 2; ++c) { const v4u w = p4[c];
        u[8 * c + 0] = bf_lo(w.x); u[8 * c + 1] = bf_hi(w.x); u[8 * c + 2] = bf_lo(w.y); u[8 * c + 3] = bf_hi(w.y);
        u[8 * c + 4] = bf_lo(w.z); u[8 * c + 5] = bf_hi(w.z); u[8 * c + 6] = bf_lo(w.w); u[8 * c + 7] = bf_hi(w.w); }
}
__device__ __forceinline__ float gelu_tanh(float v) { const float z = 0.7978845608028654f * (v + 0.044715f * v * v * v); return v * __builtin_amdgcn_rcpf(1.0f + __expf(-2.0f * z)); }

typedef float f32x16 __attribute__((ext_vector_type(16)));
typedef short bf16x8 __attribute__((ext_vector_type(8)));
typedef unsigned long long u64x2 __attribute__((ext_vector_type(2)));
typedef __bf16 bf16x2_t __attribute__((ext_vector_type(2)));
typedef float f32x2_t __attribute__((ext_vector_type(2)));
#define MFMA32(a, b, c) __builtin_amdgcn_mfma_f32_32x32x16_bf16((a), (b), (c), 0, 0, 0)
constexpr int VSTR = 36;
constexpr float LOG2E = 1.4426950408889634f;
__device__ __forceinline__ unsigned cvtpk(float lo, float hi) { f32x2_t v = {lo, hi}; bf16x2_t b = __builtin_convertvector(v, bf16x2_t); return __builtin_bit_cast(unsigned, b); }
__device__ __forceinline__ float wave_max(float v) {
#pragma unroll
    for (int o = 1; o < 64; o <<= 1) v = fmaxf(v, __shfl_xor(v, o));
    return v;
}
template <int MODE>
__device__ __forceinline__ void attn_pass(const bf16* Pb, int kcol, int vcol, const bf16x8 (&qf)[4], int q_tok, int kbase, int kstride, int cstride, int nchunks, int maxd,
                                          float c2, float slope2, float negB2, const float* rb, int wr0, int wc0, unsigned char* vt, int r, int h, f32x16 (&o)[2], float& lsum) {
    const int lr = (r + 32 * h) >> 3, pc = (r + 32 * h) & 7, lane31 = r;
    const int dlo = max(-maxd, -q_tok); const unsigned dspan = (unsigned)(min(maxd, SEQ - 1 - q_tok) - dlo);
    const unsigned vt_lds = (unsigned)(size_t)(LAS unsigned char*)vt;
    unsigned char* kst = vt + 6656;
    v4u kn[4], vn[4];
    const unsigned char* Pk = (const unsigned char*)(Pb + kcol); const unsigned char* Pv = (const unsigned char*)(Pb + vcol);
#pragma unroll
    for (int i = 0; i < 4; ++i) { const int kt = kbase + kstride * (lr + 8 * i); const unsigned off = (unsigned)min(max(kt, 0), SEQ - 1) * (unsigned)(NPROJ * 2) + (unsigned)(16 * pc);
        kn[i] = *(const v4u*)(Pk + off); vn[i] = *(const v4u*)(Pv + off); }
    for (int c = 0; c < nchunks; ++c) {
#pragma unroll
        for (int i = 0; i < 4; ++i) {
            *(v4u*)(kst + (lr + 8 * i) * 144 + 16 * pc) = kn[i];
            *(v4u*)(vt + (lr + 8 * i) * 144 + 16 * pc) = vn[i];
        }
        asm volatile("" ::: "memory");
        if (c + 1 < nchunks) {
#pragma unroll
            for (int i = 0; i < 4; ++i) { const int kt = kbase + cstride * (c + 1) + kstride * (lr + 8 * i); const unsigned off = (unsigned)min(max(kt, 0), SEQ - 1) * (unsigned)(NPROJ * 2) + (unsigned)(16 * pc);
                kn[i] = *(const v4u*)(Pk + off); vn[i] = *(const v4u*)(Pv + off); }
        }
        f32x16 s;
#pragma unroll
        for (int i = 0; i < 16; ++i) s[i] = 0.f;
        __builtin_amdgcn_s_setprio(1);
#pragma unroll
        for (int ks = 0; ks < 4; ++ks) s = MFMA32(*(const bf16x8*)(kst + r * 144 + 32 * ks + 16 * h), qf[ks], s);
        __builtin_amdgcn_s_setprio(0);
        asm volatile("" ::: "memory");
        const int k0 = kbase + cstride * c + kstride * (4 * h);
        const int dl0 = k0 - q_tok;
        float p[16];
#pragma unroll
        for (int i = 0; i < 16; ++i) {
            const int k = k0 + kstride * ((i & 3) + 8 * (i >> 2));
            float pv;
            if (MODE == 0) {
                const int dl = dl0 + kstride * ((i & 3) + 8 * (i >> 2));
                const bool valid = (unsigned)(dl - dlo) <= dspan;
                const float s2 = fmaf(__builtin_fabsf((float)dl), -slope2, fmaf(s[i], c2, negB2));
                pv = valid ? __builtin_amdgcn_exp2f(s2) : 0.f;
            } else {
                const int kcl = k & 63, krw = k >> 6;
                const bool valid = ((unsigned)(kcl - wc0) < 16u) && ((unsigned)(krw - wr0) < 8u);
                int idx = (krw - (q_tok >> 6) + 7) * 31 + (kcl - (q_tok & 63) + 15);
                idx = min(max(idx, 0), 15 * 31 - 1);
                const float s2 = fmaf(s[i], c2, fmaf(rb[idx], LOG2E, negB2));
                pv = valid ? __builtin_amdgcn_exp2f(s2) : 0.f;
            }
            p[i] = pv; lsum += pv;
        }
        bf16x8 pf[2];
#pragma unroll
        for (int sx = 0; sx < 2; ++sx) { v4u w; w.x = cvtpk(p[8 * sx + 0], p[8 * sx + 1]); w.y = cvtpk(p[8 * sx + 2], p[8 * sx + 3]); w.z = cvtpk(p[8 * sx + 4], p[8 * sx + 5]); w.w = cvtpk(p[8 * sx + 6], p[8 * sx + 7]);
            pf[sx] = __builtin_bit_cast(bf16x8, w); }
        asm volatile("s_waitcnt lgkmcnt(0)" ::: "memory");
#pragma unroll
        for (int dt = 0; dt < 2; ++dt)
#pragma unroll
            for (int sx = 0; sx < 2; ++sx) {
                const unsigned a0 = vt_lds + (unsigned)((16 * sx + 4 * h + ((lane31 & 15) >> 2)) * 144 + 64 * dt + 32 * ((lane31 >> 4) & 1) + 8 * (lane31 & 3));
                typedef short v4i16_t __attribute__((ext_vector_type(4)));
                const v4i16_t t0 = __builtin_amdgcn_ds_read_tr16_b64_v4i16((LAS v4i16_t*)(size_t)a0), t1 = __builtin_amdgcn_ds_read_tr16_b64_v4i16((LAS v4i16_t*)(size_t)(a0 + 8 * 144));
                bf16x8 av; av[0] = t0[0]; av[1] = t0[1]; av[2] = t0[2]; av[3] = t0[3]; av[4] = t1[0]; av[5] = t1[1]; av[6] = t1[2]; av[7] = t1[3];
                __builtin_amdgcn_s_setprio(1);
                o[dt] = MFMA32(av, pf[sx], o[dt]);
                __builtin_amdgcn_s_setprio(0);
            }
        asm volatile("s_waitcnt lgkmcnt(0)" ::: "memory");
    }
}
__device__ __forceinline__ void attn_store(bf16* orow, const f32x16 (&o)[2], float sc, int h) {
#pragma unroll
    for (int dt = 0; dt < 2; ++dt)
#pragma unroll
        for (int g = 0; g < 4; ++g) {
            const unsigned lo = cvtpk(o[dt][4 * g + 0] * sc, o[dt][4 * g + 1] * sc), hi = cvtpk(o[dt][4 * g + 2] * sc, o[dt][4 * g + 3] * sc);
            *(unsigned long long*)(orow + 32 * dt + 8 * g + 4 * h) = (unsigned long long)lo | ((unsigned long long)hi << 32);
        }
}

typedef float f32x4a __attribute__((ext_vector_type(4)));
#define MFMA16(a, b, c) __builtin_amdgcn_mfma_f32_16x16x32_bf16((a), (b), (c), 0, 0, 0)
constexpr int XSTR = 168;
__device__ __forceinline__ void s5_bu_tile(const v4u uav, const bf16x8 (&bm)[4], int r, int h, f32x16& re0, f32x16& re1, f32x16& im0, f32x16& im1) {
    const bf16x8 ua = __builtin_bit_cast(bf16x8, uav);
    f32x16 z;
#pragma unroll
    for (int i = 0; i < 16; ++i) z[i] = 0.f;
    __builtin_amdgcn_s_setprio(1);
    re0 = MFMA32(ua, bm[0], z); re1 = MFMA32(ua, bm[1], z); im0 = MFMA32(ua, bm[2], z); im1 = MFMA32(ua, bm[3], z);
    __builtin_amdgcn_s_setprio(0);
    asm volatile("s_nop 15\n\ts_nop 3" : "+v"(re0), "+v"(re1), "+v"(im0), "+v"(im1));
#pragma unroll
    for (int i = 0; i < 16; ++i) {
        asm volatile("s_nop 1\n\tv_permlane32_swap_b32 %0, %1" : "+v"(re0[i]), "+v"(re1[i]));
        asm volatile("s_nop 1\n\tv_permlane32_swap_b32 %0, %1" : "+v"(im0[i]), "+v"(im1[i]));
    }
}
template <bool REV, bool WRITE>
__device__ __forceinline__ void s5_scan_tile(const f32x16& re0, const f32x16& re1, const f32x16& im0, const f32x16& im1, float ar, float ai, float& xr, float& xi, unsigned short* xs, int p) {
#pragma unroll
    for (int q = 0; q < 32; ++q) {
        const int t = REV ? 31 - q : q;
        const int g8 = t >> 3, w = (t >> 2) & 1, j = t & 3, i = 4 * g8 + j;
        const float bur = w ? re1[i] : re0[i], bui = w ? im1[i] : im0[i];
        const float nr = fmaf(ar, xr, fmaf(-ai, xi, bur)), ni = fmaf(ar, xi, fmaf(ai, xr, bui));
        xr = nr; xi = ni;
        if (WRITE) { const unsigned pk = cvtpk(xr, xi); xs[t * XSTR + p] = (unsigned short)(pk & 0xffffu); xs[t * XSTR + 64 + p] = (unsigned short)(pk >> 16); }
    }
}


#define XB_TMO      128
#define XB_XCNT(j)  (256  + 64 * (j))
#define XB_XSUB(j)  (1280 + 64 * (j))
#define XB_XGEN(j)  (2304 + 64 * (j))
#define XB_TOP      3328
#define XB_TOPGEN   3392
#define XCD_BAR_WORDS 3456
#define XB_SPIN_CAP (1u << 18)

__device__ __forceinline__ unsigned xb_ld(unsigned* p)              { return __hip_atomic_load(p, __ATOMIC_RELAXED, __HIP_MEMORY_SCOPE_AGENT); }
__device__ __forceinline__ unsigned xb_add(unsigned* p, unsigned v) { return __hip_atomic_fetch_add(p, v, __ATOMIC_RELAXED, __HIP_MEMORY_SCOPE_AGENT); }
__device__ __forceinline__ unsigned xb_xcc_id() { return (unsigned)__builtin_amdgcn_s_getreg((3 << 11) | 20) & 0xFu; }
#define XB_SPIN(cond, bar) do { unsigned _sp = 0; while (cond) { __builtin_amdgcn_s_sleep(1); \
    if ((++_sp & 255u) == 0u) { if (xb_ld(&(bar)[XB_TMO])) break; if (_sp > XB_SPIN_CAP) { atomicAdd(&(bar)[XB_TMO], 1u); break; } } } } while (0)

struct XcdBarrier {
    unsigned* bar; unsigned x;
    volatile LAS unsigned* st;
};

__device__ __forceinline__ XcdBarrier xcd_barrier_post(unsigned* bar, volatile LAS unsigned* st) {
    XcdBarrier b; b.bar = bar; b.x = xb_xcc_id(); b.st = st;
    if (threadIdx.x == 0) (void)xb_add(&bar[XB_XCNT(b.x)], 1u);
    return b;
}
__device__ __forceinline__ void xcd_barrier_complete(unsigned* bar, unsigned x, unsigned& nloc, unsigned& nx) {
    const unsigned G = gridDim.x * gridDim.y * gridDim.z;
    unsigned sum, cnt, mine, sp = 0u;
    for (;;) {
        sum = 0u; cnt = 0u; mine = 0u;
#pragma unroll
        for (unsigned j = 0; j < 16; ++j) { const unsigned c = xb_ld(&bar[XB_XCNT(j)]); sum += c; cnt += (c > 0u) ? 1u : 0u; mine = (j == x) ? c : mine; }
        if (sum == G) break;
        __builtin_amdgcn_s_sleep(1);
        if ((++sp & 255u) == 0u) { if (xb_ld(&bar[XB_TMO])) break; if (sp > XB_SPIN_CAP) { atomicAdd(&bar[XB_TMO], 1u); break; } }
    }
    nloc = mine > 0u ? mine : 1u; nx = cnt > 0u ? cnt : 1u;
}

__device__ __forceinline__ void xcd_barrier(const XcdBarrier& b) {
    asm volatile("s_waitcnt vmcnt(0)" ::: "memory");
    __syncthreads();
    if (threadIdx.x == 0) {
        unsigned* bar = b.bar;
        __builtin_amdgcn_s_waitcnt(0);
        unsigned nloc = b.st[0], nx = b.st[1];
        if (nloc == 0u) { xcd_barrier_complete(bar, b.x, nloc, nx); b.st[0] = nloc; b.st[1] = nx; }
        const unsigned old = xb_add(&bar[XB_XSUB(b.x)], 1u);
        const unsigned gen = old / nloc;
        if (old + 1u == (gen + 1u) * nloc) {
            __builtin_amdgcn_fence(__ATOMIC_RELEASE, "agent");
            asm volatile("s_waitcnt vmcnt(0)" ::: "memory");
            const unsigned og = xb_add(&bar[XB_TOP], 1u);
            const unsigned tg = og / nx;
            if (og + 1u == (tg + 1u) * nx) xb_add(&bar[XB_TOPGEN], 1u);
            else XB_SPIN(xb_ld(&bar[XB_TOPGEN]) == tg, bar);
            __builtin_amdgcn_fence(__ATOMIC_ACQUIRE, "agent");
            xb_add(&bar[XB_XGEN(b.x)], 1u);
            asm volatile("s_waitcnt vmcnt(0)" ::: "memory");
        } else {
            XB_SPIN(xb_ld(&bar[XB_XGEN(b.x)]) == gen, bar);
            __builtin_amdgcn_fence(__ATOMIC_ACQUIRE, "agent");
            asm volatile("s_waitcnt vmcnt(0)" ::: "memory");
        }
    }
    __syncthreads();
}

__global__ void __launch_bounds__(NTHREADS, 2) hybrid_fwd(Args args) {
    extern __shared__ __attribute__((aligned(16))) unsigned char lds[];
    cg::grid_group grid = cg::this_grid();
    LAS unsigned char* ldsl = (LAS unsigned char*)lds;
    const int tid = threadIdx.x, lane = tid & 63, wave = __builtin_amdgcn_readfirstlane(tid >> 6);
    const int G = gridDim.x, bx = blockIdx.x;
    const int gw = bx * NWAVES + wave, NGW = G * NWAVES;
    unsigned char* ws = args.ws;
    const float* x_in = args.in[0];
    float* out = args.out;
    bf16* XB = (bf16*)(ws + WS_XB); bf16* MIX = (bf16*)(ws + WS_MIX); bf16* HB = (bf16*)(ws + WS_H); bf16* PB = (bf16*)(ws + WS_P); bf16* GB = (bf16*)(ws + WS_G);
    float* SEND = (float*)(ws + WS_SEND); float* SSQ = (float*)(ws + WS_SSQ); float* SPREP = (float*)(ws + WS_SPREP);

    volatile LAS unsigned* xb_st = (volatile LAS unsigned*)(ldsl + 131072 + 1024);
    if (tid < 2) xb_st[tid] = 0u;
    if (bx == 0) for (int i = tid; i < XCD_BAR_WORDS; i += NTHREADS) ((unsigned*)ws)[i] = 0u;
    __syncthreads();
    {
        LAS float* scr = (LAS float*)(ldsl + wave * 16384);
        constexpr int I1 = (D / 64) * (2 * FF / 32), I2 = (FF / 64) * (D / 32), I3 = (D / 64) * (NPROJ / 32), IG = (256 / 64) * (256 / 32), IO = (D / 64) * (D / 32);
        constexpr int IL = 2 * I1 + 2 * I2 + I3 + IG + IO;
        for (int it = gw; it < DEPTH * IL; it += NGW) {
            const int l = it / IL; int r = it % IL;
            bf16* wl = (bf16*)(ws + WS_W + (size_t)l * W_LAYER);
            if (r < I1) { transpose_mat(args.in[2] + (size_t)l * D * 2 * FF, D, 2 * FF, (bf16*)((unsigned char*)wl + WO_1), 1, args.in[1] + l * D, scr, r, lane); continue; } r -= I1;
            if (r < I2) { transpose_mat(args.in[3] + (size_t)l * FF * D, FF, D, (bf16*)((unsigned char*)wl + WO_2), 0, nullptr, scr, r, lane); continue; } r -= I2;
            if (r < I3) { transpose_mat(args.in[5] + (size_t)l * D * NPROJ, D, NPROJ, (bf16*)((unsigned char*)wl + WO_3), 2, args.in[4] + l * D, scr, r, lane); continue; } r -= I3;
            if (r < IG) { transpose_mat(args.in[16] + (size_t)l * 256 * 256, 256, 256, (bf16*)((unsigned char*)wl + WO_GLU), 0, nullptr, scr, r, lane); continue; } r -= IG;
            if (r < IO) { transpose_mat(args.in[18] + (size_t)l * D * D, D, D, (bf16*)((unsigned char*)wl + WO_OUT), 0, nullptr, scr, r, lane); continue; } r -= IO;
            if (r < I1) { transpose_mat(args.in[20] + (size_t)l * D * 2 * FF, D, 2 * FF, (bf16*)((unsigned char*)wl + WO_4), 1, args.in[19] + l * D, scr, r, lane); continue; } r -= I1;
            transpose_mat(args.in[21] + (size_t)l * FF * D, FF, D, (bf16*)((unsigned char*)wl + WO_5), 0, nullptr, scr, r, lane);
        }
        for (int m = gw; m < M; m += NGW) {
            const f32x4* xr = (const f32x4*)(x_in + (size_t)m * D) + lane;
            unsigned long long* o8 = (unsigned long long*)(XB + (size_t)m * D) + lane;
            float s = 0.f;
#pragma unroll
            for (int j = 0; j < 4; ++j) { const f32x4 v = xr[64 * j]; s += (v[0] * v[0] + v[1] * v[1]) + (v[2] * v[2] + v[3] * v[3]);
                o8[64 * j] = RESID_F16 ? ((unsigned long long)pg8::pk_f16r(v[0], v[1]) | ((unsigned long long)pg8::pk_f16r(v[2], v[3]) << 32)) : ((unsigned long long)pk2(v[0], v[1]) | ((unsigned long long)pk2(v[2], v[3]) << 32)); }
            s = wave_sum(s);
            if (lane < 16) SSQ[(size_t)m * 16 + lane] = (lane == 0) ? s : 0.f;
        }
        {
            int tid0 = wave * 64 + fresh_lane_id(); asm volatile("" : "+v"(tid0));
            const int i = bx * NTHREADS + tid0;
            if (i < DEPTH * 2 * 16 * 64) {
                const int p = i & 63, ldg = i >> 6;
                const double step = exp((double)args.in[10][ldg]);
                const double lr = (double)args.in[8][i], li = (double)args.in[9][i];
                const double mag = exp(lr * step);
                double sn, cs; sincos_d(li * step, sn, cs);
                const double ar = mag * cs, ai = mag * sn;
                const double den = lr * lr + li * li, xr = ar - 1.0;
                const double cr = (xr * lr + ai * li) / den, ci = (ai * lr - xr * li) / den;
                float* prm = SPREP + (size_t)ldg * SPREP_STRIDE;
                prm[p] = (float)ar; prm[64 + p] = (float)ai;
                double pr = ar, pi = ai;
#pragma unroll
                for (int k = 0; k < 8; ++k) { const double nr = pr * pr - pi * pi, ni = 2.0 * pr * pi; pr = nr; pi = ni; }
                prm[128 + p] = (float)pr; prm[192 + p] = (float)pi;
                const float* bre = args.in[11] + (size_t)i * 16; const float* bim = args.in[12] + (size_t)i * 16;
                bf16* bbf = (bf16*)(prm + 256);
                bf16* cmf = (bf16*)(prm + 1280);
                const float crf = (float)cr, cif = (float)ci;
#pragma unroll 1
                for (int c = 0; c < 16; ++c) { const float br = bre[c], bi = bim[c];
                    bbf[p * 16 + c] = (bf16)f2bf(crf * br - cif * bi); bbf[(64 + p) * 16 + c] = (bf16)f2bf(crf * bi + cif * br);
                    cmf[c * 128 + p] = (bf16)f2bf(args.in[13][((size_t)ldg * 16 + c) * 64 + p]); cmf[c * 128 + 64 + p] = (bf16)f2bf(-args.in[14][((size_t)ldg * 16 + c) * 64 + p]); }
            }
        }
    }
    grid.sync();
    const XcdBarrier xbar = xcd_barrier_post((unsigned*)ws, xb_st);

#pragma clang loop unroll(disable)
    for (int layer = 0; layer < DEPTH; ++layer) {
        unsigned char* wl = ws + WS_W + (size_t)layer * W_LAYER;
        float* ssq0 = SSQ; float* ssq1 = SSQ; float* ssq2 = SSQ; float* ssq3 = SSQ;
        for (int rep = 0; rep < REP_G1; ++rep)
        { pg8::Gemm g{XB, (const bf16*)(wl + WO_1), M, 2 * FF, D}; pg8::StaticOrder S; S.init(M, 2 * FF, G, bx);
          pg8::EpiSwiGLU E{HB, ssq0};
          pg8::gemm_phase<pg8::EpiSwiGLU, pg8::StaticOrder, true, true, (RESID_F16 != 0)>(ldsl, g, S, E, wave); }
        xcd_barrier(xbar);
        { pg8::Gemm g{HB, (const bf16*)(wl + WO_2), M, D, FF}; pg8::StaticOrder S; S.init(M, D, G, bx);
          pg8::EpiRes E{nullptr, XB, ssq1, 0.5f};
          pg8::gemm_phase<pg8::EpiRes, pg8::StaticOrder, true, true>(ldsl, g, S, E, wave); }
        xcd_barrier(xbar);
        { pg8::Gemm g{XB, (const bf16*)(wl + WO_3), M, NPROJ, D}; pg8::StaticOrder S; S.init(M, NPROJ, G, bx);
          pg8::EpiInProj E{PB, ssq1, args.in[6] + layer * 384};
          pg8::gemm_phase<pg8::EpiInProj, pg8::StaticOrder, true, true, (RESID_F16 != 0)>(ldsl, g, S, E, wave); }
        xcd_barrier(xbar);
#ifndef NO_MIX1
        {
            int lane_ = fresh_lane_id(); asm volatile("" : "+v"(lane_)); const int lane = lane_;
            constexpr int N_ATT = (M / 32) * 4;
            constexpr int N_TYPES = 5;
            constexpr int N_S5 = BATCH * NCH * 16 * 2;
            unsigned char* vt = lds + wave * 12288;
            float* rbl = (float*)(vt + 4608);
            const int r = lane & 31, h = lane >> 5;
            const float* qkg = args.in[6] + layer * 384;
            float Bg0, Bg1, Bg2, Bd0, Bd1, Bd2, Bd3;
            {
                const float a0 = wave_max(fabsf(qkg[0 * 64 + lane])), a1 = wave_max(fabsf(qkg[1 * 64 + lane])), a2 = wave_max(fabsf(qkg[2 * 64 + lane]));
                const float a3 = wave_max(fabsf(qkg[3 * 64 + lane])), a4 = wave_max(fabsf(qkg[4 * 64 + lane])), a5 = wave_max(fabsf(qkg[5 * 64 + lane]));
                Bg0 = 8.0f * a0 * a1; Bg1 = 8.0f * a2 * a3; Bg2 = 8.0f * a4 * a5;
                const float* rb0 = args.in[17] + (size_t)(layer * 4) * 15 * 31;
                float m0 = -1e30f, m1 = -1e30f, m2 = -1e30f, m3 = -1e30f;
                for (int i = lane; i < 15 * 31; i += 64) { m0 = fmaxf(m0, rb0[i]); m1 = fmaxf(m1, rb0[465 + i]); m2 = fmaxf(m2, rb0[930 + i]); m3 = fmaxf(m3, rb0[1395 + i]); }
                Bd0 = fmaxf(wave_max(m0), 0.f); Bd1 = fmaxf(wave_max(m1), 0.f); Bd2 = fmaxf(wave_max(m2), 0.f); Bd3 = fmaxf(wave_max(m3), 0.f);
            }
            const int vwv = (((G & 7) == 0) ? (bx & 7) * (G >> 3) + (bx >> 3) : bx) * NWAVES + wave;
            constexpr int N_ALL = N_TYPES * N_ATT + N_S5;
            const int per_att = (N_ATT + NGW - 1) / NGW, per_s5 = (N_S5 + NGW - 1) / NGW, per_all = N_TYPES * per_att + per_s5;
            for (int rep = 0; rep < REP_MIX1; ++rep)
            for (int ii = 0; ii < per_all; ++ii) {
                int it;
                if (ii < N_TYPES * per_att) { const int ty = ii / per_att, j = vwv * per_att + ii % per_att; if (j >= N_ATT) continue; it = ty * N_ATT + j; }
                else { const int j = vwv * per_s5 + (ii - N_TYPES * per_att); if (j >= N_S5) continue; it = N_TYPES * N_ATT + j; }
                if (it < N_TYPES * N_ATT) {
                    const int type = it / N_ATT, ri = it % N_ATT, hd = ri & 3, tile = ri >> 2, b = tile >> 9, tl = tile & 511;
                    const int gsel = (type == 0) ? 0 : (type == 4) ? 2 : 1;
                    float B = (gsel == 0) ? Bg0 : (gsel == 1) ? Bg1 : Bg2;
                    f32x16 o[2];
#pragma unroll
                    for (int i = 0; i < 16; ++i) { o[0][i] = 0.f; o[1][i] = 0.f; }
                    float lsum = 0.f;
                    bf16x8 qf[4];
                    const float c2 = 0.125f * LOG2E;
                    const bf16* Pb = PB + (size_t)b * SEQ * NPROJ;
                    if (type == 0) {
                        const int t0 = tl * 32, q_tok = t0 + r;
#pragma unroll
                        for (int ks = 0; ks < 4; ++ks) qf[ks] = __builtin_bit_cast(bf16x8, *(const v4u*)(Pb + (size_t)q_tok * NPROJ + P_AQ + 64 * hd + 16 * ks + 8 * h));
                        const float slope = exp2f(-(float)(hd + 1)); const int kvh = hd >> 1;
                        attn_pass<0>(Pb, P_AK + 64 * kvh, P_AV + 64 * kvh, qf, q_tok, t0 - 128, 1, 32, 9, 128, c2, slope * LOG2E, -B * LOG2E, nullptr, 0, 0, vt, r, h, o, lsum);
                        const float l = lsum + __shfl_xor(lsum, 32);
                        const float lse = B + __logf(l); const float gate = 1.0f / (1.0f + __expf(-(lse - args.in[7][layer * 4 + hd])));
                        attn_store(MIX + (size_t)(b * SEQ + q_tok) * D + 64 * hd, o, gate / l, h);
                    } else if (type < 4) {
                        const int dil = (type == 1) ? 1 : (type == 2) ? 4 : 16, lg = (type == 1) ? 0 : (type == 2) ? 2 : 4;
                        const int q0 = ((tl >> lg) << (lg + 5)) + (tl & (dil - 1)), q_tok = q0 + dil * r;
#pragma unroll
                        for (int ks = 0; ks < 4; ++ks) qf[ks] = __builtin_bit_cast(bf16x8, *(const v4u*)(Pb + (size_t)q_tok * NPROJ + P_CQ + 64 * hd + 16 * ks + 8 * h));
                        const float slope = exp2f(-(float)(hd + 5));
                        attn_pass<0>(Pb, P_CK + 64 * hd, P_CV + 64 * hd, qf, q_tok, q0 - 64 * dil, dil, 32 * dil, 5, 64 * dil, c2, slope * LOG2E, -B * LOG2E, nullptr, 0, 0, vt, r, h, o, lsum);
                        const float l = lsum + __shfl_xor(lsum, 32);
                        bf16* CP = (bf16*)(ws + ((type == 1) ? WS_CP0 : (type == 2) ? WS_CP1 : WS_CP2));
                        attn_store(CP + (size_t)(b * SEQ + q_tok) * 256 + 64 * hd, o, 1.0f, h);
                        if (h == 0) ((float*)(ws + WS_CL))[((size_t)(type - 1) * M + b * SEQ + q_tok) * 4 + hd] = l;
                    } else {
                        const int Rp = tl >> 2, jb = tl & 3;
                        const int qrow = 2 * Rp + (r >> 4), qc = 16 * jb + (r & 15), q_tok = qrow * 64 + qc;
                        const float* rb = args.in[17] + (size_t)(layer * 4 + hd) * 15 * 31;
                        for (int i = lane; i < 15 * 31; i += 64) rbl[i] = rb[i];
                        B += (hd == 0) ? Bd0 : (hd == 1) ? Bd1 : (hd == 2) ? Bd2 : Bd3;
#pragma unroll
                        for (int ks = 0; ks < 4; ++ks) qf[ks] = __builtin_bit_cast(bf16x8, *(const v4u*)(Pb + (size_t)q_tok * NPROJ + P_DQ + 64 * hd + 16 * ks + 8 * h));
                        const int wr0 = min(max(qrow - 4, 0), 256 - 8), wc0 = min(max(qc - 8, 0), 64 - 16);
                        const int wrmin = min(max(2 * Rp - 4, 0), 256 - 8), cs = min(max(16 * jb - 8, 0), 32);
                        asm volatile("s_waitcnt lgkmcnt(0)" ::: "memory");
                        attn_pass<1>(Pb, P_DK + 64 * hd, P_DV + 64 * hd, qf, q_tok, wrmin * 64 + cs, 1, 64, 9, 0, c2, 0.f, -B * LOG2E, rbl, wr0, wc0, vt, r, h, o, lsum);
                        const float l = lsum + __shfl_xor(lsum, 32);
                        attn_store(MIX + (size_t)(b * SEQ + q_tok) * D + 768 + 64 * hd, o, 1.0f / l, h);
                    }
                } else {
                    const int r5 = it - N_TYPES * N_ATT;
                    const int dir = r5 & 1, g = (r5 >> 1) & 15, c = (r5 >> 5) % NCH, b = (r5 >> 5) / NCH;
                    const float* prm = SPREP + (size_t)((layer * 2 + dir) * 16 + g) * SPREP_STRIDE;
                    const int p = r + 32 * h;
                    const float ar = prm[p], ai = prm[64 + p];
                    bf16x8 bm[4];
#pragma unroll
                    for (int j = 0; j < 4; ++j) bm[j] = __builtin_bit_cast(bf16x8, *(const v4u*)((const bf16*)(prm + 256) + (32 * j + r) * 16 + 8 * h));
                    float xr = 0.f, xi = 0.f;
                    const bf16* ub0 = PB + (size_t)(b * SEQ + c * S5L) * NPROJ + P_BU + 16 * g;
                    for (int tt = 0; tt < S5L / 32; ++tt) {
                        const int T = (dir == 0) ? tt : S5L / 32 - 1 - tt;
                        const v4u uc = *(const v4u*)(ub0 + (size_t)(32 * T + r) * NPROJ + 8 * h);
                        f32x16 re0, re1, im0, im1;
                        s5_bu_tile(uc, bm, r, h, re0, re1, im0, im1);
                        if (dir == 0) s5_scan_tile<false, false>(re0, re1, im0, im1, ar, ai, xr, xi, nullptr, p);
                        else s5_scan_tile<true, false>(re0, re1, im0, im1, ar, ai, xr, xi, nullptr, p);
                    }
                    float* dst = SEND + ((size_t)(((b * 2 + dir) * NCH + c) * 16 + g) * 64 + p) * 2;
                    dst[0] = xr; dst[1] = xi;
                }
            }
        }
#endif
        xcd_barrier(xbar);
#ifndef NO_MIX2
        {
            int lane_ = fresh_lane_id(); asm volatile("" : "+v"(lane_)); const int lane = lane_;
            unsigned short* xs = (unsigned short*)(lds + wave * 14848);
            float* sbuf = (float*)(lds + wave * 14848 + 10752);
            const int r = lane & 31, h = lane >> 5, p = r + 32 * h, cc = lane & 15, fq = lane >> 4;
            for (int rep = 0; rep < REP_MIX2; ++rep)
            for (int it = gw; it < BATCH * NCH * 16; it += NGW) {
                const int g = it & 15, c = (it >> 4) % NCH, b = (it >> 4) / NCH;
                const float* prm0 = SPREP + (size_t)((layer * 2 + 0) * 16 + g) * SPREP_STRIDE;
                const float* prm1 = SPREP + (size_t)((layer * 2 + 1) * 16 + g) * SPREP_STRIDE;
                const bf16* ub0 = PB + (size_t)(b * SEQ + c * S5L) * NPROJ + P_BU + 16 * g;
                float fr_ = 0.f, fi_ = 0.f, br_ = 0.f, bi_ = 0.f;
                {
                    const float alr = prm0[128 + p], ali = prm0[192 + p];
                    const float* sb = SEND + ((size_t)((b * 2 + 0) * NCH) * 16 + g) * 128 + p * 2;
                    typedef float f32x2c __attribute__((ext_vector_type(2)));
                    int j = 0;
                    for (; j + 8 <= c; j += 8) {
                        f32x2c e[8];
#pragma unroll
                        for (int k = 0; k < 8; ++k) e[k] = *(const f32x2c*)(sb + (size_t)(j + k) * 2048);
#pragma unroll
                        for (int k = 0; k < 8; ++k) { const float nr = alr * fr_ - ali * fi_ + e[k][0], ni = alr * fi_ + ali * fr_ + e[k][1]; fr_ = nr; fi_ = ni; }
                    }
                    for (; j < c; ++j) { const f32x2c e = *(const f32x2c*)(sb + (size_t)j * 2048); const float nr = alr * fr_ - ali * fi_ + e[0], ni = alr * fi_ + ali * fr_ + e[1]; fr_ = nr; fi_ = ni; }
                }
                {
                    const float alr = prm1[128 + p], ali = prm1[192 + p];
                    const float* sb = SEND + ((size_t)((b * 2 + 1) * NCH) * 16 + g) * 128 + p * 2;
                    typedef float f32x2c __attribute__((ext_vector_type(2)));
                    int j = NCH - 1;
                    for (; j - 8 >= c; j -= 8) {
                        f32x2c e[8];
#pragma unroll
                        for (int k = 0; k < 8; ++k) e[k] = *(const f32x2c*)(sb + (size_t)(j - k) * 2048);
#pragma unroll
                        for (int k = 0; k < 8; ++k) { const float nr = alr * br_ - ali * bi_ + e[k][0], ni = alr * bi_ + ali * br_ + e[k][1]; br_ = nr; bi_ = ni; }
                    }
                    for (; j > c; --j) { const f32x2c e = *(const f32x2c*)(sb + (size_t)j * 2048); const float nr = alr * br_ - ali * bi_ + e[0], ni = alr * bi_ + ali * br_ + e[1]; br_ = nr; bi_ = ni; }
                }
                const float ar0 = prm0[p], ai0 = prm0[64 + p], ar1 = prm1[p], ai1 = prm1[64 + p];
                bf16x8 bm0[4], bm1[4], cm0[4], cm1[4];
#pragma unroll
                for (int j = 0; j < 4; ++j) {
                    bm0[j] = __builtin_bit_cast(bf16x8, *(const v4u*)((const bf16*)(prm0 + 256) + (32 * j + r) * 16 + 8 * h));
                    bm1[j] = __builtin_bit_cast(bf16x8, *(const v4u*)((const bf16*)(prm1 + 256) + (32 * j + r) * 16 + 8 * h));
                    cm0[j] = __builtin_bit_cast(bf16x8, *(const v4u*)((const bf16*)(prm0 + 1280) + cc * 128 + 32 * j + 8 * fq));
                    cm1[j] = __builtin_bit_cast(bf16x8, *(const v4u*)((const bf16*)(prm1 + 1280) + cc * 128 + 32 * j + 8 * fq));
                }
                bf16x8 dg;
                { const unsigned db = f2bf(args.in[15][layer * 256 + 16 * g + cc]);
#pragma unroll
                  for (int j = 0; j < 8; ++j) dg[j] = (short)((8 * fq + j == cc) ? db : 0u); }
                const bf16* ul = ub0 + (size_t)r * NPROJ + 8 * h;
                { v4u z4 = {0u, 0u, 0u, 0u}; *(v4u*)(xs + r * XSTR + 144 + 8 * h) = z4; }
                {
                    v4u un = *(const v4u*)(ul + (size_t)(32 * (S5L / 32 - 1)) * NPROJ);
                    for (int T = S5L / 32 - 1; T >= 0; --T) {
                        sbuf[(T * 64 + p) * 2] = br_; sbuf[(T * 64 + p) * 2 + 1] = bi_;
                        if (T > 0) { const v4u uc = un; if (T > 1) un = *(const v4u*)(ul + (size_t)(32 * (T - 1)) * NPROJ);
                            f32x16 re0, re1, im0, im1;
                            s5_bu_tile(uc, bm1, r, h, re0, re1, im0, im1);
                            s5_scan_tile<true, false>(re0, re1, im0, im1, ar1, ai1, br_, bi_, nullptr, p); }
                    }
                }
                asm volatile("s_waitcnt lgkmcnt(0)" ::: "memory");
                for (int T = 0; T < S5L / 32; ++T) {
                    f32x4a y0 = {0.f, 0.f, 0.f, 0.f}, y1 = {0.f, 0.f, 0.f, 0.f};
                    const v4u uc = *(const v4u*)(ul + (size_t)(32 * T) * NPROJ);
                    {
                        *(v4u*)(xs + r * XSTR + 128 + 8 * h) = uc;
                        asm volatile("s_waitcnt lgkmcnt(0)" ::: "memory");
                        const bf16x8 u0 = *(const bf16x8*)(xs + cc * XSTR + 128 + 8 * fq), u1 = *(const bf16x8*)(xs + (16 + cc) * XSTR + 128 + 8 * fq);
                        y0 = MFMA16(u0, dg, y0); y1 = MFMA16(u1, dg, y1);
                    }
                    {
                        f32x16 re0, re1, im0, im1;
                        s5_bu_tile(uc, bm0, r, h, re0, re1, im0, im1);
                        s5_scan_tile<false, true>(re0, re1, im0, im1, ar0, ai0, fr_, fi_, xs, p);
                        asm volatile("s_waitcnt lgkmcnt(0)" ::: "memory");
#pragma unroll
                        for (int ks = 0; ks < 4; ++ks) {
                            const bf16x8 a0 = *(const bf16x8*)(xs + cc * XSTR + 32 * ks + 8 * fq), a1 = *(const bf16x8*)(xs + (16 + cc) * XSTR + 32 * ks + 8 * fq);
                            y0 = MFMA16(a0, cm0[ks], y0); y1 = MFMA16(a1, cm0[ks], y1);
                        }
                        asm volatile("s_waitcnt lgkmcnt(0)" ::: "memory");
                    }
                    {
                        float xr = sbuf[(T * 64 + p) * 2], xi = sbuf[(T * 64 + p) * 2 + 1];
                        f32x16 re0, re1, im0, im1;
                        s5_bu_tile(uc, bm1, r, h, re0, re1, im0, im1);
                        s5_scan_tile<true, true>(re0, re1, im0, im1, ar1, ai1, xr, xi, xs, p);
                        asm volatile("s_waitcnt lgkmcnt(0)" ::: "memory");
#pragma unroll
                        for (int ks = 0; ks < 4; ++ks) {
                            const bf16x8 a0 = *(const bf16x8*)(xs + cc * XSTR + 32 * ks + 8 * fq), a1 = *(const bf16x8*)(xs + (16 + cc) * XSTR + 32 * ks + 8 * fq);
                            y0 = MFMA16(a0, cm1[ks], y0); y1 = MFMA16(a1, cm1[ks], y1);
                        }
                        asm volatile("s_waitcnt lgkmcnt(0)" ::: "memory");
                    }
                    bf16* gp = GB + (size_t)(b * SEQ + c * S5L + 32 * T) * 256 + 16 * g + cc;
#pragma unroll
                    for (int j = 0; j < 4; ++j) { gp[(size_t)(4 * fq + j) * 256] = (bf16)f2bf(gelu_tanh(y0[j])); gp[(size_t)(16 + 4 * fq + j) * 256] = (bf16)f2bf(gelu_tanh(y1[j])); }
                }
            }
            {
                const bf16* CP0 = (const bf16*)(ws + WS_CP0); const bf16* CP1 = (const bf16*)(ws + WS_CP1); const bf16* CP2 = (const bf16*)(ws + WS_CP2); const float* CL = (const float*)(ws + WS_CL);
                for (int i = bx * NTHREADS + wave * 64 + lane; i < M * 32; i += 2 * G * NTHREADS) {
                    v4u a[2], bq[2], cq[2]; float inv[2]; bool ok[2];
#pragma unroll
                    for (int e = 0; e < 2; ++e) {
                        const int ie = i + e * G * NTHREADS; ok[e] = ie < M * 32; const int ic = ok[e] ? ie : i;
                        const int row = ic >> 5, pc = ic & 31, hd = pc >> 3;
                        const float l = CL[(size_t)row * 4 + hd] + CL[((size_t)M + row) * 4 + hd] + CL[((size_t)2 * M + row) * 4 + hd];
                        inv[e] = 1.0f / l;
                        a[e] = *(const v4u*)(CP0 + (size_t)row * 256 + 8 * pc); bq[e] = *(const v4u*)(CP1 + (size_t)row * 256 + 8 * pc); cq[e] = *(const v4u*)(CP2 + (size_t)row * 256 + 8 * pc);
                    }
#pragma unroll
                    for (int e = 0; e < 2; ++e) {
                        const int ie = i + e * G * NTHREADS; const int row = ie >> 5, pc = ie & 31;
                        v4u w;
                        w.x = pk2((bf_lo(a[e].x) + bf_lo(bq[e].x) + bf_lo(cq[e].x)) * inv[e], (bf_hi(a[e].x) + bf_hi(bq[e].x) + bf_hi(cq[e].x)) * inv[e]);
                        w.y = pk2((bf_lo(a[e].y) + bf_lo(bq[e].y) + bf_lo(cq[e].y)) * inv[e], (bf_hi(a[e].y) + bf_hi(bq[e].y) + bf_hi(cq[e].y)) * inv[e]);
                        w.z = pk2((bf_lo(a[e].z) + bf_lo(bq[e].z) + bf_lo(cq[e].z)) * inv[e], (bf_hi(a[e].z) + bf_hi(bq[e].z) + bf_hi(cq[e].z)) * inv[e]);
                        w.w = pk2((bf_lo(a[e].w) + bf_lo(bq[e].w) + bf_lo(cq[e].w)) * inv[e], (bf_hi(a[e].w) + bf_hi(bq[e].w) + bf_hi(cq[e].w)) * inv[e]);
                        if (ok[e]) *(v4u*)(MIX + (size_t)row * D + 512 + 8 * pc) = w;
                    }
                }
            }
        }
#endif
        xcd_barrier(xbar);
        { int kglu = 256; asm volatile("" : "+s"(kglu));
          pg8::Gemm g{GB, (const bf16*)(wl + WO_GLU), M, 256, kglu}; pg8::StaticOrder S; S.init(M, 256, G, bx);
          pg8::EpiGLU E{GB, MIX};
          pg8::gemm_phase<pg8::EpiGLU, pg8::StaticOrder, true, true>(ldsl, g, S, E, wave); }
        xcd_barrier(xbar);
        { pg8::Gemm g{MIX, (const bf16*)(wl + WO_OUT), M, D, D}; pg8::StaticOrder S; S.init(M, D, G, bx);
          pg8::EpiRes E{nullptr, XB, ssq2, 1.0f};
          pg8::gemm_phase<pg8::EpiRes, pg8::StaticOrder, true, true>(ldsl, g, S, E, wave); }
        xcd_barrier(xbar);
        { pg8::Gemm g{XB, (const bf16*)(wl + WO_4), M, 2 * FF, D}; pg8::StaticOrder S; S.init(M, 2 * FF, G, bx);
          pg8::EpiSwiGLU E{HB, ssq2};
          pg8::gemm_phase<pg8::EpiSwiGLU, pg8::StaticOrder, true, true, (RESID_F16 != 0)>(ldsl, g, S, E, wave); }
        xcd_barrier(xbar);
        { pg8::Gemm g{HB, (const bf16*)(wl + WO_5), M, D, FF}; pg8::StaticOrder S; S.init(M, D, G, bx);
          pg8::EpiRes E{layer == DEPTH - 1 ? out : nullptr, XB, ssq3, 0.5f};
          pg8::gemm_phase<pg8::EpiRes, pg8::StaticOrder, true, true>(ldsl, g, S, E, wave); }
        if (layer < DEPTH - 1) xcd_barrier(xbar);
    }
}

extern "C" void kernel_launch(void* const* d_in, const int* in_sizes, int n_in, void* d_out, int out_size, void* d_ws, size_t ws_size, hipStream_t stream) {
    static int grid = 0;
    if (grid == 0) {
        if (n_in != 22 || in_sizes[0] != M * D || out_size != M * D || ws_size < WS_END) { fprintf(stderr, "kernel_launch: unexpected shapes (n_in %d, in0 %d, out %d, ws %zu)\n", n_in, n_in > 0 ? in_sizes[0] : -1, out_size, ws_size); grid = -1; return; }
        int dev = 0, cus = 0, per_cu = 0;
        hipGetDevice(&dev);
        hipDeviceGetAttribute(&cus, hipDeviceAttributeMultiprocessorCount, dev);
        if (hipFuncSetAttribute((const void*)hybrid_fwd, hipFuncAttributeMaxDynamicSharedMemorySize, LDS_BYTES) != hipSuccess) { fprintf(stderr, "kernel_launch: hipFuncSetAttribute failed\n"); grid = -1; return; }
        if (hipOccupancyMaxActiveBlocksPerMultiprocessor(&per_cu, (const void*)hybrid_fwd, NTHREADS, LDS_BYTES) != hipSuccess || per_cu < 1) { fprintf(stderr, "kernel_launch: occupancy query says %d blocks per CU\n", per_cu); per_cu = 1; }
        (void)hipGetLastError();
        grid = cus * 1;
    }
    if (grid < 0) return;
    Args a{};
    for (int i = 0; i < 22; ++i) a.in[i] = (const float*)d_in[i];
    a.out = (float*)d_out; a.ws = (unsigned char*)d_ws;
    void* kargs[] = {&a};
    hipError_t e = hipLaunchCooperativeKernel((const void*)hybrid_fwd, dim3(grid), dim3(NTHREADS), kargs, LDS_BYTES, stream);
    if (e != hipSuccess) fprintf(stderr, "kernel_launch: cooperative launch failed: %s (grid %d)\n", hipGetErrorString(e), grid);
}
```

```cpp
#include <hip/hip_runtime.h>
#include <hip/hip_cooperative_groups.h>
#include <cstdio>
#include <cstdint>
namespace cg = cooperative_groups;
__device__ __forceinline__ int fresh_lane_id() { unsigned z = 0u; asm volatile("" : "+v"(z)); return (int)__builtin_amdgcn_mbcnt_hi(~0u, __builtin_amdgcn_mbcnt_lo(~0u, z)); }
namespace pg8 {
#define PG8_LAS __attribute__((address_space(3)))
typedef unsigned short bf16_t;
typedef short bf16x8 __attribute__((ext_vector_type(8)));
typedef float f32x4 __attribute__((ext_vector_type(4)));
typedef unsigned u32x4 __attribute__((ext_vector_type(4)));
constexpr int BM = 256, BK = 64, HALF = 128, HTB = HALF * BK * 2  , STAGE_BYTES = 8 * HTB, NXCD = 8, WGM = 8;

__host__ __device__ __forceinline__ int lds_byte(int r, int c) { const int st = (r >> 4) * 2 + (c >> 5), rr = r & 15, cc = c & 31, ob = rr * 64 + cc * 2; return st * 1024 + (ob ^ (((ob >> 9) & 1) << 5)); }
__host__ __device__ __forceinline__ void stage_rc(int b, int& R, int& C) { const int st = b / 1024, sb = b % 1024, swz = sb ^ (((sb >> 9) & 1) << 5); R = (st >> 1) * 16 + swz / 64; C = (st & 1) * 32 + (swz % 64) / 2; }
__host__ __device__ __forceinline__ int perm32(int rho) { const int n = rho >> 4, i = rho & 15; return 8 * (i >> 2) + 4 * n + (i & 3); }

struct Unit { int pm, pn; };
struct Gemm { const bf16_t* A; const bf16_t* Bt; int M, N, K; };

struct StaticOrder {
    int nM, nN, nwg, G, c;
    __host__ __device__ void init(int M, int N, int G_, int c_) { nM = M / BM; nN = N / BM; nwg = nM * nN; G = G_; c = c_; }
    __host__ __device__ bool next(int i, Unit& u) const {
        const long L = (long)i * G + c; if (L >= nwg) return false;
        int wgid = (int)L; { const int q = nwg / NXCD, r = nwg % NXCD, xcd = wgid % NXCD, off = wgid / NXCD; wgid = (xcd < r ? xcd * (q + 1) : r * (q + 1) + (xcd - r) * q) + off; }
        const int nig = WGM * nN, gid = wgid / nig, fm = gid * WGM, gsz = (nM - fm) < WGM ? (nM - fm) : WGM;
        u.pm = fm + ((wgid % nig) % gsz); u.pn = (wgid % nig) / gsz; return true;
    }
    __device__ __forceinline__ void a_ready(const Unit&) const {}
    __device__ __forceinline__ void done(const Unit&) const {}
};

__device__ __forceinline__ unsigned cvt_pk_bf16(float lo, float hi) { unsigned r; asm volatile("v_cvt_pk_bf16_f32 %0, %1, %2" : "=v"(r) : "v"(lo), "v"(hi)); return r; }
#ifndef RESID_F16
#define RESID_F16 1
#endif
__device__ __forceinline__ float bf_lo(unsigned w) { return __builtin_bit_cast(float, w << 16); }
__device__ __forceinline__ float bf_hi(unsigned w) { return __builtin_bit_cast(float, w & 0xffff0000u); }
typedef _Float16 f16x8 __attribute__((ext_vector_type(8)));
typedef _Float16 f16x2 __attribute__((ext_vector_type(2)));
typedef float f32x2e __attribute__((ext_vector_type(2)));
template <bool F16> __device__ __forceinline__ f32x4 mma16(bf16x8 a, bf16x8 b, f32x4 c) {
    if constexpr (F16) return __builtin_amdgcn_mfma_f32_16x16x32_f16(__builtin_bit_cast(f16x8, a), __builtin_bit_cast(f16x8, b), c, 0, 0, 0);
    else return __builtin_amdgcn_mfma_f32_16x16x32_bf16(a, b, c, 0, 0, 0);
}
__device__ __forceinline__ unsigned pk_f16(float lo, float hi) { f32x2e v = {lo, hi}; return __builtin_bit_cast(unsigned, __builtin_convertvector(v, f16x2)); }
#ifndef XB_BITS
#define XB_BITS 8
#endif
__device__ __forceinline__ float rnd_sig(float v) { unsigned u = __builtin_bit_cast(unsigned, v); constexpr unsigned D = 23 - XB_BITS; u = (u + ((1u << (D - 1)) - 1u) + ((u >> D) & 1u)) & ~((1u << D) - 1u); return __builtin_bit_cast(float, u); }
__device__ __forceinline__ unsigned pk_f16r(float lo, float hi) { f32x2e v = {rnd_sig(lo), rnd_sig(hi)}; return __builtin_bit_cast(unsigned, __builtin_convertvector(v, f16x2)); }
__device__ __forceinline__ float h_lo(unsigned w) { return (float)__builtin_bit_cast(f16x2, w)[0]; }
__device__ __forceinline__ float h_hi(unsigned w) { return (float)__builtin_bit_cast(f16x2, w)[1]; }
__device__ __forceinline__ float sigmoid_f(float v) { return __builtin_amdgcn_rcpf(1.0f + __expf(-v)); }
__device__ __forceinline__ float row_rstd(const float* ssq, int row) {
    const f32x4* p = (const f32x4*)(ssq + (size_t)row * 16); const f32x4 a = p[0], b = p[1], c = p[2], d = p[3];
    const float s = ((a[0] + a[1]) + (a[2] + a[3])) + ((b[0] + b[1]) + (b[2] + b[3])) + (((c[0] + c[1]) + (c[2] + c[3])) + ((d[0] + d[1]) + (d[2] + d[3])));
    return __builtin_amdgcn_rsqf(s * (1.0f / 1024.0f) + 1e-6f);
}

constexpr int RS_LDS_OFF = 131072 + 2048;
__device__ __forceinline__ void rows_rstd_pre(const float* ssq, const Unit& u, int tid, f32x4 (&pre)[2]) {
    const f32x4* p = (const f32x4*)(ssq + (size_t)(u.pm * BM + (tid >> 1)) * 16 + 8 * (tid & 1));
    pre[0] = p[0]; pre[1] = p[1];
}
__device__ __forceinline__ void rows_rstd_lds(const f32x4 (&pre)[2], int wr, int wc, int fr, int fq, float (&rs)[2][4]) {
    PG8_LAS float* rl = (PG8_LAS float*)((PG8_LAS unsigned char*)0 + RS_LDS_OFF);
    const int t = (wr * 4 + wc) * 64 + fq * 16 + fr, rowl = t >> 1, hf = t & 1;
    const f32x4 a = pre[0], b = pre[1];
    float sm = ((a[0] + a[1]) + (a[2] + a[3])) + ((b[0] + b[1]) + (b[2] + b[3]));
    sm += __shfl_xor(sm, 1);
    if (hf == 0) rl[rowl] = __builtin_amdgcn_rsqf(sm * (1.0f / 1024.0f) + 1e-6f);
    asm volatile("s_waitcnt lgkmcnt(0)" ::: "memory");
    __builtin_amdgcn_s_barrier();
#pragma unroll
    for (int ai = 0; ai < 2; ++ai)
#pragma unroll
        for (int m = 0; m < 4; ++m) rs[ai][m] = rl[ai * HALF + wr * 64 + m * 16 + fr];
}

struct EpiSwiGLU {
    static constexpr bool PERM = true, AFTER_DRAIN = false, HAS_PRE = true;
    bf16_t* H; const float* ssq;
    __device__ __forceinline__ void prefetch(const Unit& u, int tid, f32x4 (&pre)[2]) const { rows_rstd_pre(ssq, u, tid, pre); }
    __device__ __forceinline__ void operator()(const f32x4 (&acc)[2][2][4][2], const Unit& u, int wr, int wc, int fr, int fq, const f32x4 (&pre)[2]) const {
        const int row0 = u.pm * BM + wr * 64 + fr; const int hc = u.pn * 128 + wc * 32 + 8 * fq;
        float rsv[2][4]; rows_rstd_lds(pre, wr, wc, fr, fq, rsv);
#pragma unroll
        for (int ai = 0; ai < 2; ++ai)
#pragma unroll
            for (int m = 0; m < 4; ++m) {
                const int row = row0 + ai * HALF + m * 16;
                const float rs = rsv[ai][m];
                float h[8];
#pragma unroll
                for (int n = 0; n < 2; ++n)
#pragma unroll
                    for (int j = 0; j < 4; ++j) { const float g = acc[ai][0][m][n][j] * rs, up = acc[ai][1][m][n][j] * rs; h[4 * n + j] = g * sigmoid_f(g) * up; }
                u32x4 w; w.x = cvt_pk_bf16(h[0], h[1]); w.y = cvt_pk_bf16(h[2], h[3]); w.z = cvt_pk_bf16(h[4], h[5]); w.w = cvt_pk_bf16(h[6], h[7]);
                *(u32x4*)(H + (size_t)row * 2816 + hc) = w;
            }
    }
};

struct EpiRes {
    static constexpr bool PERM = true, AFTER_DRAIN = false, HAS_PRE = false;
    float* xout32; bf16_t* XB; float* ssq_next; float sc;
    __device__ __forceinline__ void operator()(const f32x4 (&acc)[2][2][4][2], const Unit& u, int wr, int wc, int fr, int fq) const {
        const int row0 = u.pm * BM + wr * 64 + fr; const int c0 = u.pn * BM + wc * 32 + 8 * fq;
#pragma unroll
        for (int ai = 0; ai < 2; ++ai) {
            u32x4 xa[4][2];
#pragma unroll
            for (int m = 0; m < 4; ++m)
#pragma unroll
                for (int bj = 0; bj < 2; ++bj) xa[m][bj] = *(const u32x4*)(XB + (size_t)(row0 + ai * HALF + m * 16) * 1024 + c0 + bj * HALF);
#pragma unroll
            for (int m = 0; m < 4; ++m) {
                const int row = row0 + ai * HALF + m * 16; float ss = 0.f;
#pragma unroll
                for (int bj = 0; bj < 2; ++bj) {
                    const size_t o = (size_t)row * 1024 + c0 + bj * HALF;
                    const u32x4 xw = xa[m][bj];
#if RESID_F16
                    f32x4 a = {h_lo(xw.x), h_hi(xw.x), h_lo(xw.y), h_hi(xw.y)}, b = {h_lo(xw.z), h_hi(xw.z), h_lo(xw.w), h_hi(xw.w)};
#else
                    f32x4 a = {bf_lo(xw.x), bf_hi(xw.x), bf_lo(xw.y), bf_hi(xw.y)}, b = {bf_lo(xw.z), bf_hi(xw.z), bf_lo(xw.w), bf_hi(xw.w)};
#endif
                    a = a + acc[ai][bj][m][0] * sc; b = b + acc[ai][bj][m][1] * sc;
                    if (xout32) { *(f32x4*)(xout32 + o) = a; *(f32x4*)(xout32 + o + 4) = b; }
#if RESID_F16
                    u32x4 w; w.x = pk_f16r(a[0], a[1]); w.y = pk_f16r(a[2], a[3]); w.z = pk_f16r(b[0], b[1]); w.w = pk_f16r(b[2], b[3]);
#else
                    u32x4 w; w.x = cvt_pk_bf16(a[0], a[1]); w.y = cvt_pk_bf16(a[2], a[3]); w.z = cvt_pk_bf16(b[0], b[1]); w.w = cvt_pk_bf16(b[2], b[3]);
#endif
                    if (!xout32) *(u32x4*)(XB + o) = w;
                    ss += (a[0] * a[0] + a[1] * a[1]) + (a[2] * a[2] + a[3] * a[3]) + (b[0] * b[0] + b[1] * b[1]) + (b[2] * b[2] + b[3] * b[3]);
                }
                ss += __shfl_xor(ss, 16); ss += __shfl_xor(ss, 32);
                if (fq == 0 && !xout32) ssq_next[(size_t)row * 16 + u.pn * 4 + wc] = ss;
            }
            asm volatile("" ::: "memory");
        }
    }
};

struct EpiInProj {
    static constexpr bool PERM = true, AFTER_DRAIN = false, HAS_PRE = true;
    bf16_t* P; const float* ssq; const float* qkg;
    __device__ __forceinline__ void prefetch(const Unit& u, int tid, f32x4 (&pre)[2]) const { rows_rstd_pre(ssq, u, tid, pre); }
    __device__ __forceinline__ void operator()(const f32x4 (&acc)[2][2][4][2], const Unit& u, int wr, int wc, int fr, int fq, const f32x4 (&pre)[2]) const {
        const int row0 = u.pm * BM + wr * 64 + fr; const int hh = 4 * u.pn + wc;
        int gidx = -1;
        if (hh < 4) gidx = 0; else if (hh < 6) gidx = 1; else if (hh < 12) gidx = -1; else if (hh < 16) gidx = 2; else if (hh < 20) gidx = 3; else if (hh < 24) gidx = -1; else if (hh < 28) gidx = 4; else if (hh < 32) gidx = 5;
        const int cb = u.pn * BM + wc * 64 + 8 * fq;
        float rsv[2][4]; rows_rstd_lds(pre, wr, wc, fr, fq, rsv);
        f32x4 gv[2][2];
#pragma unroll
        for (int bj = 0; bj < 2; ++bj)
#pragma unroll
            for (int n = 0; n < 2; ++n) gv[bj][n] = (gidx >= 0) ? *(const f32x4*)(qkg + gidx * 64 + 32 * bj + 8 * fq + 4 * n) : (f32x4){1.f, 1.f, 1.f, 1.f};
#pragma unroll
        for (int ai = 0; ai < 2; ++ai)
#pragma unroll
            for (int m = 0; m < 4; ++m) {
                const int row = row0 + ai * HALF + m * 16;
                const float rs = rsv[ai][m];
                f32x4 v[2][2]; float ss = 0.f;
#pragma unroll
                for (int bj = 0; bj < 2; ++bj)
#pragma unroll
                    for (int n = 0; n < 2; ++n) { v[bj][n] = acc[ai][bj][m][n] * rs; const f32x4 t = v[bj][n]; ss += (t[0] * t[0] + t[1] * t[1]) + (t[2] * t[2] + t[3] * t[3]); }
                if (gidx >= 0) {
                    ss += __shfl_xor(ss, 16); ss += __shfl_xor(ss, 32);
                    const float r2 = __builtin_amdgcn_rsqf(ss * (1.0f / 64.0f) + 1e-6f);
#pragma unroll
                    for (int bj = 0; bj < 2; ++bj)
#pragma unroll
                        for (int n = 0; n < 2; ++n) v[bj][n] = v[bj][n] * r2 * gv[bj][n];
                }
#pragma unroll
                for (int bj = 0; bj < 2; ++bj) {
                    u32x4 w; w.x = cvt_pk_bf16(v[bj][0][0], v[bj][0][1]); w.y = cvt_pk_bf16(v[bj][0][2], v[bj][0][3]); w.z = cvt_pk_bf16(v[bj][1][0], v[bj][1][1]); w.w = cvt_pk_bf16(v[bj][1][2], v[bj][1][3]);
                    *(u32x4*)(P + (size_t)row * 2304 + cb + 32 * bj) = w;
                }
            }
    }
};

struct EpiGLU {
    static constexpr bool PERM = true, AFTER_DRAIN = false, HAS_PRE = false;
    const bf16_t* G; bf16_t* MIX;
    __device__ __forceinline__ void operator()(const f32x4 (&acc)[2][2][4][2], const Unit& u, int wr, int wc, int fr, int fq) const {
        const int row0 = u.pm * BM + wr * 64 + fr; const int c0 = wc * 32 + 8 * fq;
#pragma unroll
        for (int ai = 0; ai < 2; ++ai) {
            u32x4 gq[4][2];
#pragma unroll
            for (int m = 0; m < 4; ++m)
#pragma unroll
                for (int bj = 0; bj < 2; ++bj) gq[m][bj] = *(const u32x4*)(G + (size_t)(row0 + ai * HALF + m * 16) * 256 + c0 + bj * HALF);
#pragma unroll
            for (int m = 0; m < 4; ++m) {
                const int row = row0 + ai * HALF + m * 16;
#pragma unroll
                for (int bj = 0; bj < 2; ++bj) {
                    const int c = c0 + bj * HALF;
                    const u32x4 gw = gq[m][bj];
                    const f32x4 a0 = acc[ai][bj][m][0], a1 = acc[ai][bj][m][1];
                    u32x4 w;
                    w.x = cvt_pk_bf16(bf_lo(gw.x) * sigmoid_f(a0[0]), bf_hi(gw.x) * sigmoid_f(a0[1]));
                    w.y = cvt_pk_bf16(bf_lo(gw.y) * sigmoid_f(a0[2]), bf_hi(gw.y) * sigmoid_f(a0[3]));
                    w.z = cvt_pk_bf16(bf_lo(gw.z) * sigmoid_f(a1[0]), bf_hi(gw.z) * sigmoid_f(a1[1]));
                    w.w = cvt_pk_bf16(bf_lo(gw.w) * sigmoid_f(a1[2]), bf_hi(gw.w) * sigmoid_f(a1[3]));
                    *(u32x4*)(MIX + (size_t)row * 1024 + 256 + c) = w;
                }
            }
            asm volatile("" ::: "memory");
        }
    }
};

template <class Epi, class Sched, bool ALIGN_EPI = false, bool SP2 = false, bool F16 = false>
__device__ __forceinline__ void gemm_phase(PG8_LAS unsigned char* lds, const Gemm g, const Sched& S, const Epi& E, const int wave_id) {
    int tid_ = wave_id * 64 + fresh_lane_id(); asm volatile("" : "+v"(tid_));
    const int tid = tid_, wid = __builtin_amdgcn_readfirstlane(tid >> 6), lane = tid & 63, wr = wid >> 2, wc = wid & 3, fr = lane & 15, fq = lane >> 4;
    const int K = g.K, nt = K / BK;
    unsigned voffA[2], voffB[2];
#pragma unroll
    for (int i = 0; i < 2; ++i) { int R, C; stage_rc(tid * 16 + i * 8192, R, C); const int Rb = Epi::PERM ? ((R & ~31) + perm32(R & 31)) : R;
        voffA[i] = (unsigned)(R * K + C) * 2u; voffB[i] = (unsigned)(Rb * K + C) * 2u; }
    const size_t kstep = (size_t)(BK * 2);
    const size_t hstep = (size_t)HALF * K * 2;
    const size_t tstep = 2 * hstep;
    const unsigned ldsw = (unsigned)wid * 1024u;
    const int aoff = lds_byte(wr * 64 + fr, fq * 8), boff = lds_byte(wc * 32 + fr, fq * 8);
#define PG8_SA(b, h) (((b) * 2 + (h)) * HTB)
#define PG8_SB(b, h) ((4 + (b) * 2 + (h)) * HTB)
#define PG8_STAGE(bufoff, gbase, voff) do { _Pragma("unroll") for (int _i = 0; _i < 2; ++_i) \
        __builtin_amdgcn_global_load_lds((const unsigned*)((const char*)(gbase) + (voff)[_i]), (PG8_LAS unsigned*)(lds + (bufoff) + ldsw + _i * 8192), 16, 0, 0); } while (0)
#define PG8_LDA(dst, b, h) do { _Pragma("unroll") for (int m = 0; m < 4; ++m) _Pragma("unroll") for (int k = 0; k < 2; ++k) dst[m][k] = *(const PG8_LAS bf16x8*)(lds + PG8_SA(b, h) + aoff + m * 2048 + k * 1024); } while (0)
#define PG8_LDB(dst, b, h) do { _Pragma("unroll") for (int n = 0; n < 2; ++n) _Pragma("unroll") for (int k = 0; k < 2; ++k) dst[n][k] = *(const PG8_LAS bf16x8*)(lds + PG8_SB(b, h) + boff + n * 2048 + k * 1024); } while (0)
#define PG8_MMA(ai, bj, At, Bt) do { __builtin_amdgcn_s_setprio(1); _Pragma("unroll") for (int m = 0; m < 4; ++m) _Pragma("unroll") for (int n = 0; n < 2; ++n) _Pragma("unroll") for (int k = 0; k < 2; ++k) \
        acc[ai][bj][m][n] = mma16<F16>(Bt[n][k], At[m][k], acc[ai][bj][m][n]); __builtin_amdgcn_s_setprio(0); } while (0)
#define PG8_WAIT_V(n) asm volatile("s_waitcnt vmcnt(" #n ")" ::: "memory")
#define PG8_WAIT_L(n) asm volatile("s_waitcnt lgkmcnt(" #n ")" ::: "memory")
#define PG8_BAR __builtin_amdgcn_s_barrier()
#define PG8_SCHED __builtin_amdgcn_sched_barrier(0)
    Unit cur, nxt; int ui = 0;
    if (!S.next(0, cur)) return;
    f32x4 acc[2][2][4][2];
#pragma unroll
    for (int a = 0; a < 2; ++a)
#pragma unroll
        for (int b = 0; b < 2; ++b)
#pragma unroll
            for (int m = 0; m < 4; ++m)
#pragma unroll
                for (int n = 0; n < 2; ++n) acc[a][b][m][n] = (f32x4){0.f, 0.f, 0.f, 0.f};
    bf16x8 At[4][2], B0[2][2], B1[2][2];
    f32x4 epre[2];
    const char* cA = (const char*)g.A + (size_t)cur.pm * tstep; const char* cB = (const char*)g.Bt + (size_t)cur.pn * tstep;
    S.a_ready(cur);
    if constexpr (SP2) {
        PG8_STAGE(PG8_SB(0, 0), cB, voffB); PG8_STAGE(PG8_SB(0, 1), cB + hstep, voffB); PG8_STAGE(PG8_SA(0, 0), cA, voffA); PG8_STAGE(PG8_SA(0, 1), cA + hstep, voffA);
        if (wr == 1) PG8_BAR;
        PG8_WAIT_V(2); PG8_BAR;
        PG8_STAGE(PG8_SB(1, 0), cB + kstep, voffB); PG8_STAGE(PG8_SA(1, 0), cA + kstep, voffA); PG8_STAGE(PG8_SB(1, 1), cB + hstep + kstep, voffB);
        PG8_WAIT_V(6); PG8_BAR;
    } else {
        PG8_STAGE(PG8_SB(0, 0), cB, voffB); PG8_STAGE(PG8_SA(0, 0), cA, voffA); PG8_STAGE(PG8_SB(0, 1), cB + hstep, voffB); PG8_STAGE(PG8_SA(0, 1), cA + hstep, voffA);
        if (wr == 1) PG8_BAR;
        PG8_WAIT_V(4); PG8_BAR;
        PG8_STAGE(PG8_SB(1, 0), cB + kstep, voffB); PG8_STAGE(PG8_SA(1, 0), cA + kstep, voffA); PG8_STAGE(PG8_SB(1, 1), cB + hstep + kstep, voffB);
        PG8_WAIT_V(6); PG8_BAR;
    }
    for (;;) {
        const bool has_next = S.next(ui + 1, nxt);
        const char* nA = has_next ? (const char*)g.A + (size_t)nxt.pm * tstep : cA; const char* nB = has_next ? (const char*)g.Bt + (size_t)nxt.pn * tstep : cB;
        for (int t = 0; t < nt; t += 2) {
            const bool last = (t == nt - 2);
            if constexpr (Epi::HAS_PRE) { if (last) E.prefetch(cur, tid, epre); }
            const char* a1 = cA + (size_t)(t + 1) * kstep;
            const char* a2 = last ? nA : cA + (size_t)(t + 2) * kstep; const char* b2 = last ? nB : cB + (size_t)(t + 2) * kstep;
            const char* a3 = a2 + kstep; const char* b3 = b2 + kstep;
            if (last && has_next) S.a_ready(nxt);
            if constexpr (SP2) {
            PG8_LDB(B0, 0, 0); PG8_LDB(B1, 0, 1); PG8_SCHED; PG8_LDA(At, 0, 0); PG8_STAGE(PG8_SA(1, 1), a1 + hstep, voffA);
            PG8_WAIT_V(8); PG8_WAIT_L(0); PG8_BAR; PG8_MMA(0, 0, At, B0); PG8_MMA(0, 1, At, B1); PG8_BAR; PG8_SCHED;
            PG8_LDA(At, 0, 1); PG8_STAGE(PG8_SB(0, 0), b2, voffB); PG8_STAGE(PG8_SB(0, 1), b2 + hstep, voffB); PG8_STAGE(PG8_SA(0, 0), a2, voffA);
            PG8_WAIT_V(8); PG8_WAIT_L(0); PG8_BAR; PG8_MMA(1, 0, At, B0); PG8_MMA(1, 1, At, B1); PG8_BAR; PG8_SCHED;
            PG8_LDB(B0, 1, 0); PG8_LDB(B1, 1, 1); PG8_SCHED; PG8_LDA(At, 1, 0); PG8_STAGE(PG8_SA(0, 1), a2 + hstep, voffA);
            PG8_WAIT_V(8); PG8_WAIT_L(0); PG8_BAR; PG8_MMA(0, 0, At, B0); PG8_MMA(0, 1, At, B1); PG8_BAR; PG8_SCHED;
            PG8_LDA(At, 1, 1); PG8_STAGE(PG8_SB(1, 0), b3, voffB); PG8_STAGE(PG8_SB(1, 1), b3 + hstep, voffB); PG8_STAGE(PG8_SA(1, 0), a3, voffA);
            PG8_WAIT_V(8); PG8_WAIT_L(0); PG8_BAR; PG8_MMA(1, 0, At, B0); PG8_MMA(1, 1, At, B1); PG8_BAR; PG8_SCHED;
            } else {
            PG8_LDB(B0, 0, 0); PG8_SCHED; PG8_LDA(At, 0, 0); PG8_STAGE(PG8_SA(1, 1), a1 + hstep, voffA);
            PG8_WAIT_L(8); PG8_BAR; PG8_WAIT_L(0); PG8_MMA(0, 0, At, B0); PG8_BAR; PG8_SCHED;
            PG8_LDB(B1, 0, 1); PG8_STAGE(PG8_SB(0, 0), b2, voffB);
            PG8_BAR; PG8_WAIT_L(0); PG8_MMA(0, 1, At, B1); PG8_BAR;
            PG8_LDA(At, 0, 1); PG8_STAGE(PG8_SA(0, 0), a2, voffA);
            PG8_BAR; PG8_WAIT_L(0); PG8_MMA(1, 0, At, B0); PG8_BAR; PG8_SCHED;
            PG8_STAGE(PG8_SB(0, 1), b2 + hstep, voffB);
            PG8_WAIT_V(6); PG8_BAR; PG8_MMA(1, 1, At, B1); PG8_BAR;
            PG8_LDB(B0, 1, 0); PG8_SCHED; PG8_LDA(At, 1, 0); PG8_STAGE(PG8_SA(0, 1), a2 + hstep, voffA);
            PG8_WAIT_L(8); PG8_BAR; PG8_WAIT_L(0); PG8_MMA(0, 0, At, B0); PG8_BAR; PG8_SCHED;
            PG8_LDB(B1, 1, 1); PG8_STAGE(PG8_SB(1, 0), b3, voffB);
            PG8_BAR; PG8_WAIT_L(0); PG8_MMA(0, 1, At, B1); PG8_BAR;
            PG8_LDA(At, 1, 1); PG8_STAGE(PG8_SA(1, 0), a3, voffA);
            PG8_BAR; PG8_WAIT_L(0); PG8_MMA(1, 0, At, B0); PG8_BAR; PG8_SCHED;
            PG8_STAGE(PG8_SB(1, 1), b3 + hstep, voffB);
            PG8_WAIT_V(6); PG8_BAR; PG8_MMA(1, 1, At, B1); PG8_BAR;
            }
        }
        if constexpr (ALIGN_EPI) { if (wr == 0) PG8_BAR; }
        if constexpr (!Epi::AFTER_DRAIN) { if constexpr (Epi::HAS_PRE) E(acc, cur, wr, wc, fr, fq, epre); else E(acc, cur, wr, wc, fr, fq); S.done(cur); }
        if (!has_next) break;
#pragma unroll
        for (int a = 0; a < 2; ++a)
#pragma unroll
            for (int b = 0; b < 2; ++b)
#pragma unroll
                for (int m = 0; m < 4; ++m)
#pragma unroll
                    for (int n = 0; n < 2; ++n) acc[a][b][m][n] = (f32x4){0.f, 0.f, 0.f, 0.f};
        cur = nxt; cA = nA; cB = nB; ++ui;
        if constexpr (ALIGN_EPI) { if (wr == 1) PG8_BAR; }
    }
    PG8_WAIT_V(0);
    if constexpr (!ALIGN_EPI) { if (wr == 0) PG8_BAR; }
    PG8_BAR;
    if constexpr (Epi::AFTER_DRAIN) { E.fused(acc, cur, wr, wc, fr, fq, lds, wid, lane); S.done(cur); }
#undef PG8_SA
#undef PG8_SB
#undef PG8_STAGE
#undef PG8_LDA
#undef PG8_LDB
#undef PG8_MMA
#undef PG8_WAIT_V
#undef PG8_WAIT_L
#undef PG8_BAR
#undef PG8_SCHED
}
}
#define LAS __attribute__((address_space(3)))
typedef unsigned short bf16;
typedef unsigned v4u __attribute__((ext_vector_type(4)));
typedef float f32x4 __attribute__((ext_vector_type(4)));
#define LDS_WAIT() asm volatile("s_waitcnt lgkmcnt(0)" ::: "memory")

constexpr int NWAVES = 8, NTHREADS = 512;
constexpr int BATCH = 2, SEQ = 16384, M = BATCH * SEQ, D = 1024, FF = 2816, NPROJ = 2304, DEPTH = 4;
constexpr int P_AQ = 0, P_AK = 256, P_AV = 384, P_BU = 512, P_CQ = 768, P_CK = 1024, P_CV = 1280, P_DQ = 1536, P_DK = 1792, P_DV = 2048;
constexpr int S5L = 256, NCH = SEQ / S5L;
constexpr size_t MiB = 1u << 20;
constexpr size_t WS_W = 4 * MiB, W_LAYER = 40 * MiB;
constexpr size_t WO_1 = 0, WO_2 = 11 * MiB, WO_3 = 33 * MiB / 2, WO_GLU = 21 * MiB, WO_OUT = 43 * MiB / 2, WO_4 = 47 * MiB / 2, WO_5 = 69 * MiB / 2;
constexpr size_t WS_XB = 164 * MiB, WS_MIX = 228 * MiB, WS_H = 292 * MiB, WS_P = WS_H, WS_G = WS_H + 144 * MiB;
constexpr size_t WS_SEND = 468 * MiB, WS_SSQ = 476 * MiB, WS_SPREP = 478 * MiB, WS_END = 512 * MiB;
constexpr size_t WS_CP0 = 452 * MiB, WS_CP1 = 480 * MiB, WS_CP2 = 496 * MiB, WS_CL = 470 * MiB;
constexpr int SPREP_STRIDE = 2560;
constexpr int LDS_BYTES = 147456;
#ifndef REP_MIX1
#define REP_MIX1 1
#endif
#ifndef REP_MIX2
#define REP_MIX2 1
#endif
#ifndef REP_G1
#define REP_G1 1
#endif

__device__ __forceinline__ unsigned f2bf(float f) { unsigned u = __builtin_bit_cast(unsigned, f); return (u + 0x7fffu + ((u >> 16) & 1u)) >> 16; }
__device__ __forceinline__ unsigned pk2(float lo, float hi) { return f2bf(lo) | (f2bf(hi) << 16); }
__device__ __forceinline__ float bf_lo(unsigned w) { return __builtin_bit_cast(float, w << 16); }
__device__ __forceinline__ float bf_hi(unsigned w) { return __builtin_bit_cast(float, w & 0xffff0000u); }
__device__ __forceinline__ float wave_sum(float v) {
#pragma unroll
    for (int o = 1; o < 64; o <<= 1) v += __shfl_xor(v, o);
    return v;
}

struct Args { const float* in[22]; float* out; unsigned char* ws; };

__device__ __forceinline__ void transpose_item(const float* W, int K, int N, bf16* WT, int nrow0, int col0, int k0, const float* gain, LAS float* scr, int lane, bool f16) {
    float wv[32];
#pragma unroll
    for (int i = 0; i < 32; ++i) { const int kk = 2 * i + (lane >> 5); wv[i] = W[(size_t)(k0 + kk) * N + col0 + (lane & 31)]; }
#pragma unroll
    for (int i = 0; i < 32; ++i) { const int kk = 2 * i + (lane >> 5); float w = wv[i]; if (gain) w *= gain[k0 + kk]; scr[kk * 33 + (lane & 31)] = w; }
    LDS_WAIT();
    const int c = lane & 7;
#pragma unroll
    for (int j = 0; j < 4; ++j) { const int n = (lane >> 3) + 8 * j; const LAS float* s = scr + (8 * c) * 33 + n;
        v4u o;
        if (f16) {
#define W8(v) __builtin_bit_cast(float, f2bf(v) << 16)
            o.x = pg8::pk_f16(W8(s[0 * 33]), W8(s[1 * 33])); o.y = pg8::pk_f16(W8(s[2 * 33]), W8(s[3 * 33])); o.z = pg8::pk_f16(W8(s[4 * 33]), W8(s[5 * 33])); o.w = pg8::pk_f16(W8(s[6 * 33]), W8(s[7 * 33]));
#undef W8
        }
        else { o.x = pk2(s[0 * 33], s[1 * 33]); o.y = pk2(s[2 * 33], s[3 * 33]); o.z = pk2(s[4 * 33], s[5 * 33]); o.w = pk2(s[6 * 33], s[7 * 33]); }
        *(v4u*)(WT + (size_t)(nrow0 + n) * K + k0 + 8 * c) = o; }
    LDS_WAIT();
}
__device__ __forceinline__ void transpose_mat(const float* W, int K, int N, bf16* WT, int mode, const float* gain, LAS float* scr, int item, int lane) {
    const int nblk = N / 32, kb = item / nblk, nb = item % nblk, n0 = 32 * nb;
    int col0 = n0;
    if (mode == 1) { const int pn = n0 >> 8, bj = (n0 >> 7) & 1, r0 = n0 & 127; col0 = bj * FF + 128 * pn + r0; }
    else if (mode == 2) { const int pn = n0 >> 8, bj = (n0 >> 7) & 1, wc = (n0 >> 5) & 3; col0 = 256 * pn + 64 * wc + 32 * bj; }
    transpose_item(W, K, N, WT, n0, col0, 64 * kb, gain, scr, lane, RESID_F16 && mode != 0);
}

__device__ __forceinline__ void sincos_d(double th, double& s, double& c) {
    const double k = __builtin_rint(th * 0.63661977236758134308);
    double r = __builtin_fma(-k, 1.57079632679489655800e+00, th);
    r = __builtin_fma(-k, 6.12323399573676603587e-17, r);
    const double r2 = r * r;
    double sp = -1.0 / 1307674368000.0; sp = sp * r2 + 1.0 / 6227020800.0; sp = sp * r2 - 1.0 / 39916800.0; sp = sp * r2 + 1.0 / 362880.0; sp = sp * r2 - 1.0 / 5040.0; sp = sp * r2 + 1.0 / 120.0; sp = sp * r2 - 1.0 / 6.0; sp = sp * r2 + 1.0;
    const double sr = sp * r;
    double cp = 1.0 / 20922789888000.0; cp = cp * r2 - 1.0 / 87178291200.0; cp = cp * r2 + 1.0 / 479001600.0; cp = cp * r2 - 1.0 / 3628800.0; cp = cp * r2 + 1.0 / 40320.0; cp = cp * r2 - 1.0 / 720.0; cp = cp * r2 + 1.0 / 24.0; cp = cp * r2 - 0.5; cp = cp * r2 + 1.0;
    const int q = ((int)k) & 3;
    s = (q == 0) ? sr : (q == 1) ? cp : (q == 2) ? -sr : -cp;
    c = (q == 0) ? cp : (q == 1) ? -sr : (q == 2) ? -cp : sr;
}

__device__ __forceinline__ void load_row64(const bf16* p, float (&q)[64]) {
    const v4u* p4 = (const v4u*)p;
#pragma unroll
    for (int c = 0; c < 8; ++c) { const v4u w = p4[c];
        q[8 * c + 0] = bf_lo(w.x); q[8 * c + 1] = bf_hi(w.x); q[8 * c + 2] = bf_lo(w.y); q[8 * c + 3] = bf_hi(w.y);
        q[8 * c + 4] = bf_lo(w.z); q[8 * c + 5] = bf_hi(w.z); q[8 * c + 6] = bf_lo(w.w); q[8 * c + 7] = bf_hi(w.w); }
}
__device__ __forceinline__ void attn_visit(const bf16* kp, const bf16* vp, float bias, const float (&q)[64], float (&o)[64], float& mx, float& l) {
    const v4u* k4 = (const v4u*)kp; const v4u* v4 = (const v4u*)vp;
    float s0 = 0.f, s1 = 0.f;
#pragma unroll
    for (int c = 0; c < 8; ++c) { const v4u w = k4[c];
        s0 += q[8 * c + 0] * bf_lo(w.x); s1 += q[8 * c + 1] * bf_hi(w.x); s0 += q[8 * c + 2] * bf_lo(w.y); s1 += q[8 * c + 3] * bf_hi(w.y);
        s0 += q[8 * c + 4] * bf_lo(w.z); s1 += q[8 * c + 5] * bf_hi(w.z); s0 += q[8 * c + 6] * bf_lo(w.w); s1 += q[8 * c + 7] * bf_hi(w.w); }
    const float s = (s0 + s1) * 0.125f + bias;
    const float mn = fmaxf(mx, s), corr = __expf(mx - mn), p = __expf(s - mn);
    l = l * corr + p; mx = mn;
#pragma unroll
    for (int c = 0; c < 8; ++c) { const v4u w = v4[c];
        o[8 * c + 0] = o[8 * c + 0] * corr + p * bf_lo(w.x); o[8 * c + 1] = o[8 * c + 1] * corr + p * bf_hi(w.x);
        o[8 * c + 2] = o[8 * c + 2] * corr + p * bf_lo(w.y); o[8 * c + 3] = o[8 * c + 3] * corr + p * bf_hi(w.y);
        o[8 * c + 4] = o[8 * c + 4] * corr + p * bf_lo(w.z); o[8 * c + 5] = o[8 * c + 5] * corr + p * bf_hi(w.z);
        o[8 * c + 6] = o[8 * c + 6] * corr + p * bf_lo(w.w); o[8 * c + 7] = o[8 * c + 7] * corr + p * bf_hi(w.w); }
}
__device__ __forceinline__ void store_row64(bf16* p, const float (&o)[64], float sc) {
    v4u* p4 = (v4u*)p;
#pragma unroll
    for (int c = 0; c < 8; ++c) { v4u w; w.x = pk2(o[8 * c + 0] * sc, o[8 * c + 1] * sc); w.y = pk2(o[8 * c + 2] * sc, o[8 * c + 3] * sc); w.z = pk2(o[8 * c + 4] * sc, o[8 * c + 5] * sc); w.w = pk2(o[8 * c + 6] * sc, o[8 * c + 7] * sc); p4[c] = w; }
}

__device__ __forceinline__ void load_u16(const bf16* p, float (&u)[16]) {
    const v4u* p4 = (const v4u*)p;
#pragma unroll
    for (int c = 0; c < 2; ++c) { const v4u w = p4[c];
        u[8 * c + 0] = bf_lo(w.x); u[8 * c + 1] = bf_hi(w.x); u[8 * c + 2] = bf_lo(w.y); u[8 * c + 3] = bf_hi(w.y);
        u[8 * c + 4] = bf_lo(w.z); u[8 * c + 5] = bf_hi(w.z); u[8 * c + 6] = bf_lo(w.w); u[8 * c + 7] = bf_hi(w.w); }
}
__device__ __forceinline__ float gelu_tanh(float v) { const float z = 0.7978845608028654f * (v + 0.044715f * v * v * v); return v * __builtin_amdgcn_rcpf(1.0f + __expf(-2.0f * z)); }

typedef float f32x16 __attribute__((ext_vector_type(16)));
typedef short bf16x8 __attribute__((ext_vector_type(8)));
typedef unsigned long long u64x2 __attribute__((ext_vector_type(2)));
typedef __bf16 bf16x2_t __attribute__((ext_vector_type(2)));
typedef float f32x2_t __attribute__((ext_vector_type(2)));
#define MFMA32(a, b, c) __builtin_amdgcn_mfma_f32_32x32x16_bf16((a), (b), (c), 0, 0, 0)
constexpr int VSTR = 36;
constexpr float LOG2E = 1.4426950408889634f;
__device__ __forceinline__ unsigned cvtpk(float lo, float hi) { f32x2_t v = {lo, hi}; bf16x2_t b = __builtin_convertvector(v, bf16x2_t); return __builtin_bit_cast(unsigned, b); }
__device__ __forceinline__ float wave_max(float v) {
#pragma unroll
    for (int o = 1; o < 64; o <<= 1) v = fmaxf(v, __shfl_xor(v, o));
    return v;
}
template <int MODE>
__device__ __forceinline__ void attn_pass(const bf16* Pb, int kcol, int vcol, const bf16x8 (&qf)[4], int q_tok, int kbase, int kstride, int cstride, int nchunks, int maxd,
                                          float c2, float slope2, float negB2, const float* rb, int wr0, int wc0, unsigned char* vt, int r, int h, f32x16 (&o)[2], float& lsum) {
    const int lr = (r + 32 * h) >> 3, pc = (r + 32 * h) & 7, lane31 = r;
    const int dlo = max(-maxd, -q_tok); const unsigned dspan = (unsigned)(min(maxd, SEQ - 1 - q_tok) - dlo);
    const unsigned vt_lds = (unsigned)(size_t)(LAS unsigned char*)vt;
    unsigned char* kst = vt + 6656;
    v4u kn[4], vn[4];
    const unsigned char* Pk = (const unsigned char*)(Pb + kcol); const unsigned char* Pv = (const unsigned char*)(Pb + vcol);
#pragma unroll
    for (int i = 0; i < 4; ++i) { const int kt = kbase + kstride * (lr + 8 * i); const unsigned off = (unsigned)min(max(kt, 0), SEQ - 1) * (unsigned)(NPROJ * 2) + (unsigned)(16 * pc);
        kn[i] = *(const v4u*)(Pk + off); vn[i] = *(const v4u*)(Pv + off); }
    for (int c = 0; c < nchunks; ++c) {
#pragma unroll
        for (int i = 0; i < 4; ++i) {
            *(v4u*)(kst + (lr + 8 * i) * 144 + 16 * pc) = kn[i];
            *(v4u*)(vt + (lr + 8 * i) * 144 + 16 * pc) = vn[i];
        }
        asm volatile("" ::: "memory");
        if (c + 1 < nchunks) {
#pragma unroll
            for (int i = 0; i < 4; ++i) { const int kt = kbase + cstride * (c + 1) + kstride * (lr + 8 * i); const unsigned off = (unsigned)min(max(kt, 0), SEQ - 1) * (unsigned)(NPROJ * 2) + (unsigned)(16 * pc);
                kn[i] = *(const v4u*)(Pk + off); vn[i] = *(const v4u*)(Pv + off); }
        }
        f32x16 s;
#pragma unroll
        for (int i = 0; i < 16; ++i) s[i] = 0.f;
#pragma unroll
        for (int ks = 0; ks < 4; ++ks) s = MFMA32(*(const bf16x8*)(kst + r * 144 + 32 * ks + 16 * h), qf[ks], s);
        asm volatile("" ::: "memory");
        const int k0 = kbase + cstride * c + kstride * (4 * h);
        const int dl0 = k0 - q_tok;
        float p[16];
#pragma unroll
        for (int i = 0; i < 16; ++i) {
            const int k = k0 + kstride * ((i & 3) + 8 * (i >> 2));
            float pv;
            if (MODE == 0) {
                const int dl = dl0 + kstride * ((i & 3) + 8 * (i >> 2));
                const bool valid = (unsigned)(dl - dlo) <= dspan;
                const float s2 = fmaf(__builtin_fabsf((float)dl), -slope2, fmaf(s[i], c2, negB2));
                pv = valid ? __builtin_amdgcn_exp2f(s2) : 0.f;
            } else {
                const int kcl = k & 63, krw = k >> 6;
                const bool valid = ((unsigned)(kcl - wc0) < 16u) && ((unsigned)(krw - wr0) < 8u);
                int idx = (krw - (q_tok >> 6) + 7) * 31 + (kcl - (q_tok & 63) + 15);
                idx = min(max(idx, 0), 15 * 31 - 1);
                const float s2 = fmaf(s[i], c2, fmaf(rb[idx], LOG2E, negB2));
                pv = valid ? __builtin_amdgcn_exp2f(s2) : 0.f;
            }
            p[i] = pv; lsum += pv;
        }
        bf16x8 pf[2];
#pragma unroll
        for (int sx = 0; sx < 2; ++sx) { v4u w; w.x = cvtpk(p[8 * sx + 0], p[8 * sx + 1]); w.y = cvtpk(p[8 * sx + 2], p[8 * sx + 3]); w.z = cvtpk(p[8 * sx + 4], p[8 * sx + 5]); w.w = cvtpk(p[8 * sx + 6], p[8 * sx + 7]);
            pf[sx] = __builtin_bit_cast(bf16x8, w); }
        asm volatile("s_waitcnt lgkmcnt(0)" ::: "memory");
#pragma unroll
        for (int dt = 0; dt < 2; ++dt)
#pragma unroll
            for (int sx = 0; sx < 2; ++sx) {
                const unsigned a0 = vt_lds + (unsigned)((16 * sx + 4 * h + ((lane31 & 15) >> 2)) * 144 + 64 * dt + 32 * ((lane31 >> 4) & 1) + 8 * (lane31 & 3));
                typedef short v4i16_t __attribute__((ext_vector_type(4)));
                const v4i16_t t0 = __builtin_amdgcn_ds_read_tr16_b64_v4i16((LAS v4i16_t*)(size_t)a0), t1 = __builtin_amdgcn_ds_read_tr16_b64_v4i16((LAS v4i16_t*)(size_t)(a0 + 8 * 144));
                bf16x8 av; av[0] = t0[0]; av[1] = t0[1]; av[2] = t0[2]; av[3] = t0[3]; av[4] = t1[0]; av[5] = t1[1]; av[6] = t1[2]; av[7] = t1[3];
                o[dt] = MFMA32(av, pf[sx], o[dt]);
            }
        asm volatile("s_waitcnt lgkmcnt(0)" ::: "memory");
    }
}
__device__ __forceinline__ void attn_store(bf16* orow, const f32x16 (&o)[2], float sc, int h) {
#pragma unroll
    for (int dt = 0; dt < 2; ++dt)
#pragma unroll
        for (int g = 0; g < 4; ++g) {
            const unsigned lo = cvtpk(o[dt][4 * g + 0] * sc, o[dt][4 * g + 1] * sc), hi = cvtpk(o[dt][4 * g + 2] * sc, o[dt][4 * g + 3] * sc);
            *(unsigned long long*)(orow + 32 * dt + 8 * g + 4 * h) = (unsigned long long)lo | ((unsigned long long)hi << 32);
        }
}

typedef float f32x4a __attribute__((ext_vector_type(4)));
#define MFMA16(a, b, c) __builtin_amdgcn_mfma_f32_16x16x32_bf16((a), (b), (c), 0, 0, 0)
constexpr int XSTR = 168;
__device__ __forceinline__ void s5_bu_tile(const v4u uav, const bf16x8 (&bm)[4], int r, int h, f32x16& re0, f32x16& re1, f32x16& im0, f32x16& im1) {
    const bf16x8 ua = __builtin_bit_cast(bf16x8, uav);
    f32x16 z;
#pragma unroll
    for (int i = 0; i < 16; ++i) z[i] = 0.f;
    re0 = MFMA32(ua, bm[0], z); re1 = MFMA32(ua, bm[1], z); im0 = MFMA32(ua, bm[2], z); im1 = MFMA32(ua, bm[3], z);
    asm volatile("s_nop 15\n\ts_nop 3" : "+v"(re0), "+v"(re1), "+v"(im0), "+v"(im1));
#pragma unroll
    for (int i = 0; i < 16; ++i) {
        asm volatile("s_nop 1\n\tv_permlane32_swap_b32 %0, %1" : "+v"(re0[i]), "+v"(re1[i]));
        asm volatile("s_nop 1\n\tv_permlane32_swap_b32 %0, %1" : "+v"(im0[i]), "+v"(im1[i]));
    }
}
template <bool REV, bool WRITE>
__device__ __forceinline__ void s5_scan_tile(const f32x16& re0, const f32x16& re1, const f32x16& im0, const f32x16& im1, float ar, float ai, float& xr, float& xi, unsigned short* xs, int p) {
#pragma unroll
    for (int q = 0; q < 32; ++q) {
        const int t = REV ? 31 - q : q;
        const int g8 = t >> 3, w = (t >> 2) & 1, j = t & 3, i = 4 * g8 + j;
        const float bur = w ? re1[i] : re0[i], bui = w ? im1[i] : im0[i];
        const float nr = fmaf(ar, xr, fmaf(-ai, xi, bur)), ni = fmaf(ar, xi, fmaf(ai, xr, bui));
        xr = nr; xi = ni;
        if (WRITE) { const unsigned pk = cvtpk(xr, xi); xs[t * XSTR + p] = (unsigned short)(pk & 0xffffu); xs[t * XSTR + 64 + p] = (unsigned short)(pk >> 16); }
    }
}


#define XB_TMO      128
#define XB_XCNT(j)  (256  + 64 * (j))
#define XB_XSUB(j)  (1280 + 64 * (j))
#define XB_XGEN(j)  (2304 + 64 * (j))
#define XB_TOP      3328
#define XB_TOPGEN   3392
#define XCD_BAR_WORDS 3456
#define XB_SPIN_CAP (1u << 18)

__device__ __forceinline__ unsigned xb_ld(unsigned* p)              { return __hip_atomic_load(p, __ATOMIC_RELAXED, __HIP_MEMORY_SCOPE_AGENT); }
__device__ __forceinline__ unsigned xb_add(unsigned* p, unsigned v) { return __hip_atomic_fetch_add(p, v, __ATOMIC_RELAXED, __HIP_MEMORY_SCOPE_AGENT); }
__device__ __forceinline__ unsigned xb_xcc_id() { return (unsigned)__builtin_amdgcn_s_getreg((3 << 11) | 20) & 0xFu; }
#define XB_SPIN(cond, bar) do { unsigned _sp = 0; while (cond) { __builtin_amdgcn_s_sleep(1); \
    if ((++_sp & 255u) == 0u) { if (xb_ld(&(bar)[XB_TMO])) break; if (_sp > XB_SPIN_CAP) { atomicAdd(&(bar)[XB_TMO], 1u); break; } } } } while (0)

struct XcdBarrier {
    unsigned* bar; unsigned x;
    volatile LAS unsigned* st;
};

__device__ __forceinline__ XcdBarrier xcd_barrier_post(unsigned* bar, volatile LAS unsigned* st) {
    XcdBarrier b; b.bar = bar; b.x = xb_xcc_id(); b.st = st;
    if (threadIdx.x == 0) (void)xb_add(&bar[XB_XCNT(b.x)], 1u);
    return b;
}
__device__ __forceinline__ void xcd_barrier_complete(unsigned* bar, unsigned x, unsigned& nloc, unsigned& nx) {
    const unsigned G = gridDim.x * gridDim.y * gridDim.z;
    unsigned sum, cnt, mine, sp = 0u;
    for (;;) {
        sum = 0u; cnt = 0u; mine = 0u;
#pragma unroll
        for (unsigned j = 0; j < 16; ++j) { const unsigned c = xb_ld(&bar[XB_XCNT(j)]); sum += c; cnt += (c > 0u) ? 1u : 0u; mine = (j == x) ? c : mine; }
        if (sum == G) break;
        __builtin_amdgcn_s_sleep(1);
        if ((++sp & 255u) == 0u) { if (xb_ld(&bar[XB_TMO])) break; if (sp > XB_SPIN_CAP) { atomicAdd(&bar[XB_TMO], 1u); break; } }
    }
    nloc = mine > 0u ? mine : 1u; nx = cnt > 0u ? cnt : 1u;
}

__device__ __forceinline__ void xcd_barrier(const XcdBarrier& b) {
    asm volatile("s_waitcnt vmcnt(0)" ::: "memory");
    __syncthreads();
    if (threadIdx.x == 0) {
        unsigned* bar = b.bar;
        __builtin_amdgcn_s_waitcnt(0);
        unsigned nloc = b.st[0], nx = b.st[1];
        if (nloc == 0u) { xcd_barrier_complete(bar, b.x, nloc, nx); b.st[0] = nloc; b.st[1] = nx; }
        const unsigned old = xb_add(&bar[XB_XSUB(b.x)], 1u);
        const unsigned gen = old / nloc;
        if (old + 1u == (gen + 1u) * nloc) {
            __builtin_amdgcn_fence(__ATOMIC_RELEASE, "agent");
            asm volatile("s_waitcnt vmcnt(0)" ::: "memory");
            const unsigned og = xb_add(&bar[XB_TOP], 1u);
            const unsigned tg = og / nx;
            if (og + 1u == (tg + 1u) * nx) xb_add(&bar[XB_TOPGEN], 1u);
            else XB_SPIN(xb_ld(&bar[XB_TOPGEN]) == tg, bar);
            __builtin_amdgcn_fence(__ATOMIC_ACQUIRE, "agent");
            xb_add(&bar[XB_XGEN(b.x)], 1u);
            asm volatile("s_waitcnt vmcnt(0)" ::: "memory");
        } else {
            XB_SPIN(xb_ld(&bar[XB_XGEN(b.x)]) == gen, bar);
            __builtin_amdgcn_fence(__ATOMIC_ACQUIRE, "agent");
            asm volatile("s_waitcnt vmcnt(0)" ::: "memory");
        }
    }
    __syncthreads();
}

__global__ void __launch_bounds__(NTHREADS, 2) hybrid_fwd(Args args) {
    extern __shared__ __attribute__((aligned(16))) unsigned char lds[];
    cg::grid_group grid = cg::this_grid();
    LAS unsigned char* ldsl = (LAS unsigned char*)lds;
    const int tid = threadIdx.x, lane = tid & 63, wave = __builtin_amdgcn_readfirstlane(tid >> 6);
    const int G = gridDim.x, bx = blockIdx.x;
    const int gw = bx * NWAVES + wave, NGW = G * NWAVES;
    unsigned char* ws = args.ws;
    const float* x_in = args.in[0];
    float* out = args.out;
    bf16* XB = (bf16*)(ws + WS_XB); bf16* MIX = (bf16*)(ws + WS_MIX); bf16* HB = (bf16*)(ws + WS_H); bf16* PB = (bf16*)(ws + WS_P); bf16* GB = (bf16*)(ws + WS_G);
    float* SEND = (float*)(ws + WS_SEND); float* SSQ = (float*)(ws + WS_SSQ); float* SPREP = (float*)(ws + WS_SPREP);

    volatile LAS unsigned* xb_st = (volatile LAS unsigned*)(ldsl + 131072 + 1024);
    if (tid < 2) xb_st[tid] = 0u;
    if (bx == 0) for (int i = tid; i < XCD_BAR_WORDS; i += NTHREADS) ((unsigned*)ws)[i] = 0u;
    __syncthreads();
    {
        LAS float* scr = (LAS float*)(ldsl + wave * 16384);
        constexpr int I1 = (D / 64) * (2 * FF / 32), I2 = (FF / 64) * (D / 32), I3 = (D / 64) * (NPROJ / 32), IG = (256 / 64) * (256 / 32), IO = (D / 64) * (D / 32);
        constexpr int IL = 2 * I1 + 2 * I2 + I3 + IG + IO;
        for (int it = gw; it < DEPTH * IL; it += NGW) {
            const int l = it / IL; int r = it % IL;
            bf16* wl = (bf16*)(ws + WS_W + (size_t)l * W_LAYER);
            if (r < I1) { transpose_mat(args.in[2] + (size_t)l * D * 2 * FF, D, 2 * FF, (bf16*)((unsigned char*)wl + WO_1), 1, args.in[1] + l * D, scr, r, lane); continue; } r -= I1;
            if (r < I2) { transpose_mat(args.in[3] + (size_t)l * FF * D, FF, D, (bf16*)((unsigned char*)wl + WO_2), 0, nullptr, scr, r, lane); continue; } r -= I2;
            if (r < I3) { transpose_mat(args.in[5] + (size_t)l * D * NPROJ, D, NPROJ, (bf16*)((unsigned char*)wl + WO_3), 2, args.in[4] + l * D, scr, r, lane); continue; } r -= I3;
            if (r < IG) { transpose_mat(args.in[16] + (size_t)l * 256 * 256, 256, 256, (bf16*)((unsigned char*)wl + WO_GLU), 0, nullptr, scr, r, lane); continue; } r -= IG;
            if (r < IO) { transpose_mat(args.in[18] + (size_t)l * D * D, D, D, (bf16*)((unsigned char*)wl + WO_OUT), 0, nullptr, scr, r, lane); continue; } r -= IO;
            if (r < I1) { transpose_mat(args.in[20] + (size_t)l * D * 2 * FF, D, 2 * FF, (bf16*)((unsigned char*)wl + WO_4), 1, args.in[19] + l * D, scr, r, lane); continue; } r -= I1;
            transpose_mat(args.in[21] + (size_t)l * FF * D, FF, D, (bf16*)((unsigned char*)wl + WO_5), 0, nullptr, scr, r, lane);
        }
        for (int m = gw; m < M; m += NGW) {
            const f32x4* xr = (const f32x4*)(x_in + (size_t)m * D) + lane;
            unsigned long long* o8 = (unsigned long long*)(XB + (size_t)m * D) + lane;
            float s = 0.f;
#pragma unroll
            for (int j = 0; j < 4; ++j) { const f32x4 v = xr[64 * j]; s += (v[0] * v[0] + v[1] * v[1]) + (v[2] * v[2] + v[3] * v[3]);
                o8[64 * j] = RESID_F16 ? ((unsigned long long)pg8::pk_f16r(v[0], v[1]) | ((unsigned long long)pg8::pk_f16r(v[2], v[3]) << 32)) : ((unsigned long long)pk2(v[0], v[1]) | ((unsigned long long)pk2(v[2], v[3]) << 32)); }
            s = wave_sum(s);
            if (lane < 16) SSQ[(size_t)m * 16 + lane] = (lane == 0) ? s : 0.f;
        }
        {
            int tid0 = wave * 64 + fresh_lane_id(); asm volatile("" : "+v"(tid0));
            const int i = bx * NTHREADS + tid0;
            if (i < DEPTH * 2 * 16 * 64) {
                const int p = i & 63, ldg = i >> 6;
                const double step = exp((double)args.in[10][ldg]);
                const double lr = (double)args.in[8][i], li = (double)args.in[9][i];
                const double mag = exp(lr * step);
                double sn, cs; sincos_d(li * step, sn, cs);
                const double ar = mag * cs, ai = mag * sn;
                const double den = lr * lr + li * li, xr = ar - 1.0;
                const double cr = (xr * lr + ai * li) / den, ci = (ai * lr - xr * li) / den;
                float* prm = SPREP + (size_t)ldg * SPREP_STRIDE;
                prm[p] = (float)ar; prm[64 + p] = (float)ai;
                double pr = ar, pi = ai;
#pragma unroll
                for (int k = 0; k < 8; ++k) { const double nr = pr * pr - pi * pi, ni = 2.0 * pr * pi; pr = nr; pi = ni; }
                prm[128 + p] = (float)pr; prm[192 + p] = (float)pi;
                const float* bre = args.in[11] + (size_t)i * 16; const float* bim = args.in[12] + (size_t)i * 16;
                bf16* bbf = (bf16*)(prm + 256);
                bf16* cmf = (bf16*)(prm + 1280);
                const float crf = (float)cr, cif = (float)ci;
#pragma unroll 1
                for (int c = 0; c < 16; ++c) { const float br = bre[c], bi = bim[c];
                    bbf[p * 16 + c] = (bf16)f2bf(crf * br - cif * bi); bbf[(64 + p) * 16 + c] = (bf16)f2bf(crf * bi + cif * br);
                    cmf[c * 128 + p] = (bf16)f2bf(args.in[13][((size_t)ldg * 16 + c) * 64 + p]); cmf[c * 128 + 64 + p] = (bf16)f2bf(-args.in[14][((size_t)ldg * 16 + c) * 64 + p]); }
            }
        }
    }
    grid.sync();
    const XcdBarrier xbar = xcd_barrier_post((unsigned*)ws, xb_st);

#pragma clang loop unroll(disable)
    for (int layer = 0; layer < DEPTH; ++layer) {
        unsigned char* wl = ws + WS_W + (size_t)layer * W_LAYER;
        float* ssq0 = SSQ; float* ssq1 = SSQ; float* ssq2 = SSQ; float* ssq3 = SSQ;
        for (int rep = 0; rep < REP_G1; ++rep)
        { pg8::Gemm g{XB, (const bf16*)(wl + WO_1), M, 2 * FF, D}; pg8::StaticOrder S; S.init(M, 2 * FF, G, bx);
          pg8::EpiSwiGLU E{HB, ssq0};
          pg8::gemm_phase<pg8::EpiSwiGLU, pg8::StaticOrder, true, true, (RESID_F16 != 0)>(ldsl, g, S, E, wave); }
        xcd_barrier(xbar);
        { pg8::Gemm g{HB, (const bf16*)(wl + WO_2), M, D, FF}; pg8::StaticOrder S; S.init(M, D, G, bx);
          pg8::EpiRes E{nullptr, XB, ssq1, 0.5f};
          pg8::gemm_phase<pg8::EpiRes, pg8::StaticOrder, true, true>(ldsl, g, S, E, wave); }
        xcd_barrier(xbar);
        { pg8::Gemm g{XB, (const bf16*)(wl + WO_3), M, NPROJ, D}; pg8::StaticOrder S; S.init(M, NPROJ, G, bx);
          pg8::EpiInProj E{PB, ssq1, args.in[6] + layer * 384};
          pg8::gemm_phase<pg8::EpiInProj, pg8::StaticOrder, true, true, (RESID_F16 != 0)>(ldsl, g, S, E, wave); }
        xcd_barrier(xbar);
#ifndef NO_MIX1
        {
            int lane_ = fresh_lane_id(); asm volatile("" : "+v"(lane_)); const int lane = lane_;
            constexpr int N_ATT = (M / 32) * 4;
            constexpr int N_TYPES = 5;
            constexpr int N_S5 = BATCH * NCH * 16 * 2;
            unsigned char* vt = lds + wave * 12288;
            float* rbl = (float*)(vt + 4608);
            const int r = lane & 31, h = lane >> 5;
            const float* qkg = args.in[6] + layer * 384;
            float Bg0, Bg1, Bg2, Bd0, Bd1, Bd2, Bd3;
            {
                const float a0 = wave_max(fabsf(qkg[0 * 64 + lane])), a1 = wave_max(fabsf(qkg[1 * 64 + lane])), a2 = wave_max(fabsf(qkg[2 * 64 + lane]));
                const float a3 = wave_max(fabsf(qkg[3 * 64 + lane])), a4 = wave_max(fabsf(qkg[4 * 64 + lane])), a5 = wave_max(fabsf(qkg[5 * 64 + lane]));
                Bg0 = 8.0f * a0 * a1; Bg1 = 8.0f * a2 * a3; Bg2 = 8.0f * a4 * a5;
                const float* rb0 = args.in[17] + (size_t)(layer * 4) * 15 * 31;
                float m0 = -1e30f, m1 = -1e30f, m2 = -1e30f, m3 = -1e30f;
                for (int i = lane; i < 15 * 31; i += 64) { m0 = fmaxf(m0, rb0[i]); m1 = fmaxf(m1, rb0[465 + i]); m2 = fmaxf(m2, rb0[930 + i]); m3 = fmaxf(m3, rb0[1395 + i]); }
                Bd0 = fmaxf(wave_max(m0), 0.f); Bd1 = fmaxf(wave_max(m1), 0.f); Bd2 = fmaxf(wave_max(m2), 0.f); Bd3 = fmaxf(wave_max(m3), 0.f);
            }
            const int vwv = (((G & 7) == 0) ? (bx & 7) * (G >> 3) + (bx >> 3) : bx) * NWAVES + wave;
            constexpr int N_ALL = N_TYPES * N_ATT + N_S5;
            const int per_att = (N_ATT + NGW - 1) / NGW, per_s5 = (N_S5 + NGW - 1) / NGW, per_all = N_TYPES * per_att + per_s5;
            for (int rep = 0; rep < REP_MIX1; ++rep)
            for (int ii = 0; ii < per_all; ++ii) {
                int it;
                if (ii < N_TYPES * per_att) { const int ty = ii / per_att, j = vwv * per_att + ii % per_att; if (j >= N_ATT) continue; it = ty * N_ATT + j; }
                else { const int j = vwv * per_s5 + (ii - N_TYPES * per_att); if (j >= N_S5) continue; it = N_TYPES * N_ATT + j; }
                if (it < N_TYPES * N_ATT) {
                    const int type = it / N_ATT, ri = it % N_ATT, hd = ri & 3, tile = ri >> 2, b = tile >> 9, tl = tile & 511;
                    const int gsel = (type == 0) ? 0 : (type == 4) ? 2 : 1;
                    float B = (gsel == 0) ? Bg0 : (gsel == 1) ? Bg1 : Bg2;
                    f32x16 o[2];
#pragma unroll
                    for (int i = 0; i < 16; ++i) { o[0][i] = 0.f; o[1][i] = 0.f; }
                    float lsum = 0.f;
                    bf16x8 qf[4];
                    const float c2 = 0.125f * LOG2E;
                    const bf16* Pb = PB + (size_t)b * SEQ * NPROJ;
                    if (type == 0) {
                        const int t0 = tl * 32, q_tok = t0 + r;
#pragma unroll
                        for (int ks = 0; ks < 4; ++ks) qf[ks] = __builtin_bit_cast(bf16x8, *(const v4u*)(Pb + (size_t)q_tok * NPROJ + P_AQ + 64 * hd + 16 * ks + 8 * h));
                        const float slope = exp2f(-(float)(hd + 1)); const int kvh = hd >> 1;
                        attn_pass<0>(Pb, P_AK + 64 * kvh, P_AV + 64 * kvh, qf, q_tok, t0 - 128, 1, 32, 9, 128, c2, slope * LOG2E, -B * LOG2E, nullptr, 0, 0, vt, r, h, o, lsum);
                        const float l = lsum + __shfl_xor(lsum, 32);
                        const float lse = B + __logf(l); const float gate = 1.0f / (1.0f + __expf(-(lse - args.in[7][layer * 4 + hd])));
                        attn_store(MIX + (size_t)(b * SEQ + q_tok) * D + 64 * hd, o, gate / l, h);
                    } else if (type < 4) {
                        const int dil = (type == 1) ? 1 : (type == 2) ? 4 : 16, lg = (type == 1) ? 0 : (type == 2) ? 2 : 4;
                        const int q0 = ((tl >> lg) << (lg + 5)) + (tl & (dil - 1)), q_tok = q0 + dil * r;
#pragma unroll
                        for (int ks = 0; ks < 4; ++ks) qf[ks] = __builtin_bit_cast(bf16x8, *(const v4u*)(Pb + (size_t)q_tok * NPROJ + P_CQ + 64 * hd + 16 * ks + 8 * h));
                        const float slope = exp2f(-(float)(hd + 5));
                        attn_pass<0>(Pb, P_CK + 64 * hd, P_CV + 64 * hd, qf, q_tok, q0 - 64 * dil, dil, 32 * dil, 5, 64 * dil, c2, slope * LOG2E, -B * LOG2E, nullptr, 0, 0, vt, r, h, o, lsum);
                        const float l = lsum + __shfl_xor(lsum, 32);
                        bf16* CP = (bf16*)(ws + ((type == 1) ? WS_CP0 : (type == 2) ? WS_CP1 : WS_CP2));
                        attn_store(CP + (size_t)(b * SEQ + q_tok) * 256 + 64 * hd, o, 1.0f, h);
                        if (h == 0) ((float*)(ws + WS_CL))[((size_t)(type - 1) * M + b * SEQ + q_tok) * 4 + hd] = l;
                    } else {
                        const int Rp = tl >> 2, jb = tl & 3;
                        const int qrow = 2 * Rp + (r >> 4), qc = 16 * jb + (r & 15), q_tok = qrow * 64 + qc;
                        const float* rb = args.in[17] + (size_t)(layer * 4 + hd) * 15 * 31;
                        for (int i = lane; i < 15 * 31; i += 64) rbl[i] = rb[i];
                        B += (hd == 0) ? Bd0 : (hd == 1) ? Bd1 : (hd == 2) ? Bd2 : Bd3;
#pragma unroll
                        for (int ks = 0; ks < 4; ++ks) qf[ks] = __builtin_bit_cast(bf16x8, *(const v4u*)(Pb + (size_t)q_tok * NPROJ + P_DQ + 64 * hd + 16 * ks + 8 * h));
                        const int wr0 = min(max(qrow - 4, 0), 256 - 8), wc0 = min(max(qc - 8, 0), 64 - 16);
                        const int wrmin = min(max(2 * Rp - 4, 0), 256 - 8), cs = min(max(16 * jb - 8, 0), 32);
                        asm volatile("s_waitcnt lgkmcnt(0)" ::: "memory");
                        attn_pass<1>(Pb, P_DK + 64 * hd, P_DV + 64 * hd, qf, q_tok, wrmin * 64 + cs, 1, 64, 9, 0, c2, 0.f, -B * LOG2E, rbl, wr0, wc0, vt, r, h, o, lsum);
                        const float l = lsum + __shfl_xor(lsum, 32);
                        attn_store(MIX + (size_t)(b * SEQ + q_tok) * D + 768 + 64 * hd, o, 1.0f / l, h);
                    }
                } else {
                    const int r5 = it - N_TYPES * N_ATT;
                    const int dir = r5 & 1, g = (r5 >> 1) & 15, c = (r5 >> 5) % NCH, b = (r5 >> 5) / NCH;
                    const float* prm = SPREP + (size_t)((layer * 2 + dir) * 16 + g) * SPREP_STRIDE;
                    const int p = r + 32 * h;
                    const float ar = prm[p], ai = prm[64 + p];
                    bf16x8 bm[4];
#pragma unroll
                    for (int j = 0; j < 4; ++j) bm[j] = __builtin_bit_cast(bf16x8, *(const v4u*)((const bf16*)(prm + 256) + (32 * j + r) * 16 + 8 * h));
                    float xr = 0.f, xi = 0.f;
                    const bf16* ub0 = PB + (size_t)(b * SEQ + c * S5L) * NPROJ + P_BU + 16 * g;
                    for (int tt = 0; tt < S5L / 32; ++tt) {
                        const int T = (dir == 0) ? tt : S5L / 32 - 1 - tt;
                        const v4u uc = *(const v4u*)(ub0 + (size_t)(32 * T + r) * NPROJ + 8 * h);
                        f32x16 re0, re1, im0, im1;
                        s5_bu_tile(uc, bm, r, h, re0, re1, im0, im1);
                        if (dir == 0) s5_scan_tile<false, false>(re0, re1, im0, im1, ar, ai, xr, xi, nullptr, p);
                        else s5_scan_tile<true, false>(re0, re1, im0, im1, ar, ai, xr, xi, nullptr, p);
                    }
                    float* dst = SEND + ((size_t)(((b * 2 + dir) * NCH + c) * 16 + g) * 64 + p) * 2;
                    dst[0] = xr; dst[1] = xi;
                }
            }
        }
#endif
        xcd_barrier(xbar);
#ifndef NO_MIX2
        {
            int lane_ = fresh_lane_id(); asm volatile("" : "+v"(lane_)); const int lane = lane_;
            unsigned short* xs = (unsigned short*)(lds + wave * 14848);
            float* sbuf = (float*)(lds + wave * 14848 + 10752);
            const int r = lane & 31, h = lane >> 5, p = r + 32 * h, cc = lane & 15, fq = lane >> 4;
            for (int rep = 0; rep < REP_MIX2; ++rep)
            for (int it = gw; it < BATCH * NCH * 16; it += NGW) {
                const int g = it & 15, c = (it >> 4) % NCH, b = (it >> 4) / NCH;
                const float* prm0 = SPREP + (size_t)((layer * 2 + 0) * 16 + g) * SPREP_STRIDE;
                const float* prm1 = SPREP + (size_t)((layer * 2 + 1) * 16 + g) * SPREP_STRIDE;
                const bf16* ub0 = PB + (size_t)(b * SEQ + c * S5L) * NPROJ + P_BU + 16 * g;
                float fr_ = 0.f, fi_ = 0.f, br_ = 0.f, bi_ = 0.f;
                {
                    const float alr = prm0[128 + p], ali = prm0[192 + p];
                    const float* sb = SEND + ((size_t)((b * 2 + 0) * NCH) * 16 + g) * 128 + p * 2;
                    typedef float f32x2c __attribute__((ext_vector_type(2)));
                    int j = 0;
                    for (; j + 8 <= c; j += 8) {
                        f32x2c e[8];
#pragma unroll
                        for (int k = 0; k < 8; ++k) e[k] = *(const f32x2c*)(sb + (size_t)(j + k) * 2048);
#pragma unroll
                        for (int k = 0; k < 8; ++k) { const float nr = alr * fr_ - ali * fi_ + e[k][0], ni = alr * fi_ + ali * fr_ + e[k][1]; fr_ = nr; fi_ = ni; }
                    }
                    for (; j < c; ++j) { const f32x2c e = *(const f32x2c*)(sb + (size_t)j * 2048); const float nr = alr * fr_ - ali * fi_ + e[0], ni = alr * fi_ + ali * fr_ + e[1]; fr_ = nr; fi_ = ni; }
                }
                {
                    const float alr = prm1[128 + p], ali = prm1[192 + p];
                    const float* sb = SEND + ((size_t)((b * 2 + 1) * NCH) * 16 + g) * 128 + p * 2;
                    typedef float f32x2c __attribute__((ext_vector_type(2)));
                    int j = NCH - 1;
                    for (; j - 8 >= c; j -= 8) {
                        f32x2c e[8];
#pragma unroll
                        for (int k = 0; k < 8; ++k) e[k] = *(const f32x2c*)(sb + (size_t)(j - k) * 2048);
#pragma unroll
                        for (int k = 0; k < 8; ++k) { const float nr = alr * br_ - ali * bi_ + e[k][0], ni = alr * bi_ + ali * br_ + e[k][1]; br_ = nr; bi_ = ni; }
                    }
                    for (; j > c; --j) { const f32x2c e = *(const f32x2c*)(sb + (size_t)j * 2048); const float nr = alr * br_ - ali * bi_ + e[0], ni = alr * bi_ + ali * br_ + e[1]; br_ = nr; bi_ = ni; }
                }
                const float ar0 = prm0[p], ai0 = prm0[64 + p], ar1 = prm1[p], ai1 = prm1[64 + p];
                bf16x8 bm0[4], bm1[4], cm0[4], cm1[4];
#pragma unroll
                for (int j = 0; j < 4; ++j) {
                    bm0[j] = __builtin_bit_cast(bf16x8, *(const v4u*)((const bf16*)(prm0 + 256) + (32 * j + r) * 16 + 8 * h));
                    bm1[j] = __builtin_bit_cast(bf16x8, *(const v4u*)((const bf16*)(prm1 + 256) + (32 * j + r) * 16 + 8 * h));
                    cm0[j] = __builtin_bit_cast(bf16x8, *(const v4u*)((const bf16*)(prm0 + 1280) + cc * 128 + 32 * j + 8 * fq));
                    cm1[j] = __builtin_bit_cast(bf16x8, *(const v4u*)((const bf16*)(prm1 + 1280) + cc * 128 + 32 * j + 8 * fq));
                }
                bf16x8 dg;
                { const unsigned db = f2bf(args.in[15][layer * 256 + 16 * g + cc]);
#pragma unroll
                  for (int j = 0; j < 8; ++j) dg[j] = (short)((8 * fq + j == cc) ? db : 0u); }
                const bf16* ul = ub0 + (size_t)r * NPROJ + 8 * h;
                { v4u z4 = {0u, 0u, 0u, 0u}; *(v4u*)(xs + r * XSTR + 144 + 8 * h) = z4; }
                {
                    v4u un = *(const v4u*)(ul + (size_t)(32 * (S5L / 32 - 1)) * NPROJ);
                    for (int T = S5L / 32 - 1; T >= 0; --T) {
                        sbuf[(T * 64 + p) * 2] = br_; sbuf[(T * 64 + p) * 2 + 1] = bi_;
                        if (T > 0) { const v4u uc = un; if (T > 1) un = *(const v4u*)(ul + (size_t)(32 * (T - 1)) * NPROJ);
                            f32x16 re0, re1, im0, im1;
                            s5_bu_tile(uc, bm1, r, h, re0, re1, im0, im1);
                            s5_scan_tile<true, false>(re0, re1, im0, im1, ar1, ai1, br_, bi_, nullptr, p); }
                    }
                }
                asm volatile("s_waitcnt lgkmcnt(0)" ::: "memory");
                for (int T = 0; T < S5L / 32; ++T) {
                    f32x4a y0 = {0.f, 0.f, 0.f, 0.f}, y1 = {0.f, 0.f, 0.f, 0.f};
                    const v4u uc = *(const v4u*)(ul + (size_t)(32 * T) * NPROJ);
                    {
                        *(v4u*)(xs + r * XSTR + 128 + 8 * h) = uc;
                        asm volatile("s_waitcnt lgkmcnt(0)" ::: "memory");
                        const bf16x8 u0 = *(const bf16x8*)(xs + cc * XSTR + 128 + 8 * fq), u1 = *(const bf16x8*)(xs + (16 + cc) * XSTR + 128 + 8 * fq);
                        y0 = MFMA16(u0, dg, y0); y1 = MFMA16(u1, dg, y1);
                    }
                    {
                        f32x16 re0, re1, im0, im1;
                        s5_bu_tile(uc, bm0, r, h, re0, re1, im0, im1);
                        s5_scan_tile<false, true>(re0, re1, im0, im1, ar0, ai0, fr_, fi_, xs, p);
                        asm volatile("s_waitcnt lgkmcnt(0)" ::: "memory");
#pragma unroll
                        for (int ks = 0; ks < 4; ++ks) {
                            const bf16x8 a0 = *(const bf16x8*)(xs + cc * XSTR + 32 * ks + 8 * fq), a1 = *(const bf16x8*)(xs + (16 + cc) * XSTR + 32 * ks + 8 * fq);
                            y0 = MFMA16(a0, cm0[ks], y0); y1 = MFMA16(a1, cm0[ks], y1);
                        }
                        asm volatile("s_waitcnt lgkmcnt(0)" ::: "memory");
                    }
                    {
                        float xr = sbuf[(T * 64 + p) * 2], xi = sbuf[(T * 64 + p) * 2 + 1];
                        f32x16 re0, re1, im0, im1;
                        s5_bu_tile(uc, bm1, r, h, re0, re1, im0, im1);
                        s5_scan_tile<true, true>(re0, re1, im0, im1, ar1, ai1, xr, xi, xs, p);
                        asm volatile("s_waitcnt lgkmcnt(0)" ::: "memory");
#pragma unroll
                        for (int ks = 0; ks < 4; ++ks) {
                            const bf16x8 a0 = *(const bf16x8*)(xs + cc * XSTR + 32 * ks + 8 * fq), a1 = *(const bf16x8*)(xs + (16 + cc) * XSTR + 32 * ks + 8 * fq);
                            y0 = MFMA16(a0, cm1[ks], y0); y1 = MFMA16(a1, cm1[ks], y1);
                        }
                        asm volatile("s_waitcnt lgkmcnt(0)" ::: "memory");
                    }
#pragma unroll
                    for (int j = 0; j < 4; ++j) { xs[(4 * fq + j) * XSTR + cc] = (unsigned short)f2bf(gelu_tanh(y0[j])); xs[(16 + 4 * fq + j) * XSTR + cc] = (unsigned short)f2bf(gelu_tanh(y1[j])); }
                    asm volatile("s_waitcnt lgkmcnt(0)" ::: "memory");
                    { const v4u gw = *(const v4u*)(xs + r * XSTR + 8 * h);
                      *(v4u*)(GB + (size_t)(b * SEQ + c * S5L + 32 * T + r) * 256 + 16 * g + 8 * h) = gw; }
                    asm volatile("s_waitcnt lgkmcnt(0)" ::: "memory");
                }
            }
            {
                const bf16* CP0 = (const bf16*)(ws + WS_CP0); const bf16* CP1 = (const bf16*)(ws + WS_CP1); const bf16* CP2 = (const bf16*)(ws + WS_CP2); const float* CL = (const float*)(ws + WS_CL);
                for (int i = bx * NTHREADS + wave * 64 + lane; i < M * 32; i += 2 * G * NTHREADS) {
                    v4u a[2], bq[2], cq[2]; float inv[2]; bool ok[2];
#pragma unroll
                    for (int e = 0; e < 2; ++e) {
                        const int ie = i + e * G * NTHREADS; ok[e] = ie < M * 32; const int ic = ok[e] ? ie : i;
                        const int row = ic >> 5, pc = ic & 31, hd = pc >> 3;
                        const float l = CL[(size_t)row * 4 + hd] + CL[((size_t)M + row) * 4 + hd] + CL[((size_t)2 * M + row) * 4 + hd];
                        inv[e] = 1.0f / l;
                        a[e] = *(const v4u*)(CP0 + (size_t)row * 256 + 8 * pc); bq[e] = *(const v4u*)(CP1 + (size_t)row * 256 + 8 * pc); cq[e] = *(const v4u*)(CP2 + (size_t)row * 256 + 8 * pc);
                    }
#pragma unroll
                    for (int e = 0; e < 2; ++e) {
                        const int ie = i + e * G * NTHREADS; const int row = ie >> 5, pc = ie & 31;
                        v4u w;
                        w.x = pk2((bf_lo(a[e].x) + bf_lo(bq[e].x) + bf_lo(cq[e].x)) * inv[e], (bf_hi(a[e].x) + bf_hi(bq[e].x) + bf_hi(cq[e].x)) * inv[e]);
                        w.y = pk2((bf_lo(a[e].y) + bf_lo(bq[e].y) + bf_lo(cq[e].y)) * inv[e], (bf_hi(a[e].y) + bf_hi(bq[e].y) + bf_hi(cq[e].y)) * inv[e]);
                        w.z = pk2((bf_lo(a[e].z) + bf_lo(bq[e].z) + bf_lo(cq[e].z)) * inv[e], (bf_hi(a[e].z) + bf_hi(bq[e].z) + bf_hi(cq[e].z)) * inv[e]);
                        w.w = pk2((bf_lo(a[e].w) + bf_lo(bq[e].w) + bf_lo(cq[e].w)) * inv[e], (bf_hi(a[e].w) + bf_hi(bq[e].w) + bf_hi(cq[e].w)) * inv[e]);
                        if (ok[e]) *(v4u*)(MIX + (size_t)row * D + 512 + 8 * pc) = w;
                    }
                }
            }
        }
#endif
        xcd_barrier(xbar);
        { int kglu = 256; asm volatile("" : "+s"(kglu));
          pg8::Gemm g{GB, (const bf16*)(wl + WO_GLU), M, 256, kglu}; pg8::StaticOrder S; S.init(M, 256, G, bx);
          pg8::EpiGLU E{GB, MIX};
          pg8::gemm_phase<pg8::EpiGLU, pg8::StaticOrder, true, true>(ldsl, g, S, E, wave); }
        xcd_barrier(xbar);
        { pg8::Gemm g{MIX, (const bf16*)(wl + WO_OUT), M, D, D}; pg8::StaticOrder S; S.init(M, D, G, bx);
          pg8::EpiRes E{nullptr, XB, ssq2, 1.0f};
          pg8::gemm_phase<pg8::EpiRes, pg8::StaticOrder, true, true>(ldsl, g, S, E, wave); }
        xcd_barrier(xbar);
        { pg8::Gemm g{XB, (const bf16*)(wl + WO_4), M, 2 * FF, D}; pg8::StaticOrder S; S.init(M, 2 * FF, G, bx);
          pg8::EpiSwiGLU E{HB, ssq2};
          pg8::gemm_phase<pg8::EpiSwiGLU, pg8::StaticOrder, true, true, (RESID_F16 != 0)>(ldsl, g, S, E, wave); }
        xcd_barrier(xbar);
        { pg8::Gemm g{HB, (const bf16*)(wl + WO_5), M, D, FF}; pg8::StaticOrder S; S.init(M, D, G, bx);
          pg8::EpiRes E{layer == DEPTH - 1 ? out : nullptr, XB, ssq3, 0.5f};
          pg8::gemm_phase<pg8::EpiRes, pg8::StaticOrder, true, true>(ldsl, g, S, E, wave); }
        if (layer < DEPTH - 1) xcd_barrier(xbar);
    }
}

extern "C" void kernel_launch(void* const* d_in, const int* in_sizes, int n_in, void* d_out, int out_size, void* d_ws, size_t ws_size, hipStream_t stream) {
    static int grid = 0;
    if (grid == 0) {
        if (n_in != 22 || in_sizes[0] != M * D || out_size != M * D || ws_size < WS_END) { fprintf(stderr, "kernel_launch: unexpected shapes (n_in %d, in0 %d, out %d, ws %zu)\n", n_in, n_in > 0 ? in_sizes[0] : -1, out_size, ws_size); grid = -1; return; }
        int dev = 0, cus = 0, per_cu = 0;
        hipGetDevice(&dev);
        hipDeviceGetAttribute(&cus, hipDeviceAttributeMultiprocessorCount, dev);
        if (hipFuncSetAttribute((const void*)hybrid_fwd, hipFuncAttributeMaxDynamicSharedMemorySize, LDS_BYTES) != hipSuccess) { fprintf(stderr, "kernel_launch: hipFuncSetAttribute failed\n"); grid = -1; return; }
        if (hipOccupancyMaxActiveBlocksPerMultiprocessor(&per_cu, (const void*)hybrid_fwd, NTHREADS, LDS_BYTES) != hipSuccess || per_cu < 1) { fprintf(stderr, "kernel_launch: occupancy query says %d blocks per CU\n", per_cu); per_cu = 1; }
        (void)hipGetLastError();
        grid = cus * 1;
    }
    if (grid < 0) return;
    Args a{};
    for (int i = 0; i < 22; ++i) a.in[i] = (const float*)d_in[i];
    a.out = (float*)d_out; a.ws = (unsigned char*)d_ws;
    void* kargs[] = {&a};
    hipError_t e = hipLaunchCooperativeKernel((const void*)hybrid_fwd, dim3(grid), dim3(NTHREADS), kargs, LDS_BYTES, stream);
    if (e != hipSuccess) fprintf(stderr, "kernel_launch: cooperative launch failed: %s (grid %d)\n", hipGetErrorString(e), grid);
}
```
